# Optimizing an MI355X kernel written in HIP

```python
import math
import jax
import jax.numpy as jnp
from jax import lax
import numpy as np

D_MODEL = 1024
BATCH = 8
SEQ = 4096
DEPTH = 4

EPS = 1e-6
POOL_WINDOWS = (2, 4, 8, 16)
POOL_GROUP = D_MODEL // 8
POOL_WIDTH = len(POOL_WINDOWS) * POOL_GROUP
DIL_PAIRS = ((128, 1), (512, 4), (2048, 16))
DIL_HEADS_PER_GROUP = 4
DIL_HEADS = len(DIL_PAIRS) * DIL_HEADS_PER_GROUP
DIL_HEAD_DIM = 64
DIL_QKV_WIDTH = DIL_HEADS * DIL_HEAD_DIM
DIL_OUT_WIDTH = DIL_HEADS_PER_GROUP * DIL_HEAD_DIM
REL_BUCKETS = 32
REL_MAX_DIST = 2048
SB_HEADS = 4
SB_HEAD_DIM = 128
SB_WIDTH = SB_HEADS * SB_HEAD_DIM
SB_BLOCK = 128
S5_WIDTH = D_MODEL // 2
S5_CH = 16
S5_GROUPS = S5_WIDTH // S5_CH
S5_STATE = 64
FFN_HIDDEN = ((8 * D_MODEL + 3 * 256 - 1) // (3 * 256)) * 256
N_BRANCHES = 4
IN_WIDTH = POOL_WIDTH + 3 * DIL_QKV_WIDTH + 3 * SB_WIDTH + S5_WIDTH
BRANCH_WIDTHS = (POOL_WIDTH, DIL_OUT_WIDTH, SB_WIDTH, S5_WIDTH)
BRANCH_WIDTH = sum(BRANCH_WIDTHS)

kernel_name = 'hybrid_gated_mixer_trunk'


def rmsnorm(x, g):
    xf = x.astype(jnp.float32)
    y = xf * lax.rsqrt(jnp.mean(xf * xf, axis=-1, keepdims=True) + EPS)
    return (y * g.astype(jnp.float32)).astype(x.dtype)


def pool_mixer(u, w_grp, scale):
    B_, S_, _ = u.shape
    uf = u.astype(jnp.float32)
    cs = jnp.concatenate([jnp.zeros_like(uf[:, :1]), jnp.cumsum(uf, axis=1)], axis=1)
    t = jnp.arange(S_)
    outs = []
    for gi, w in enumerate(POOL_WINDOWS):
        sl = slice(gi * POOL_GROUP, (gi + 1) * POOL_GROUP)
        lo = jnp.maximum(t + 1 - w, 0)
        cnt = (t + 1 - lo).astype(jnp.float32)
        mean = (cs[:, 1:, sl] - cs[:, lo, sl]) / cnt[None, :, None]
        outs.append(mean - uf[:, :, sl])
    p = jnp.stack(outs, axis=2)
    y = jnp.einsum('bsgc,gcd->bsgd', p, w_grp.astype(jnp.float32)).reshape(B_, S_, POOL_WIDTH)
    return (y * scale.astype(jnp.float32)).astype(u.dtype)


def t5_bucket(dist):
    exact = REL_BUCKETS // 2
    df = jnp.maximum(dist, 1).astype(jnp.float32)
    large = exact + (jnp.log(df / exact) / math.log(REL_MAX_DIST / exact)
                     * (REL_BUCKETS - exact)).astype(jnp.int32)
    large = jnp.minimum(large, REL_BUCKETS - 1)
    return jnp.where(dist < exact, dist, large)


def dilated_group(q, k, v, bias_tab, window, dil):
    B_, S_, H, E = q.shape
    band = window // dil
    L = S_ // dil
    nb = -(-L // band)
    Lp = nb * band

    def to_sub(a):
        a = a.reshape(B_, L, dil, H, E).transpose(0, 2, 3, 1, 4)
        return jnp.pad(a, ((0, 0), (0, 0), (0, 0), (0, Lp - L), (0, 0)))

    def band_keys(a):
        a = jnp.pad(a, ((0, 0), (0, 0), (0, 0), (band, 0), (0, 0))).reshape(B_, dil, H, nb + 1, band, E)
        return jnp.concatenate([a[:, :, :, :-1], a[:, :, :, 1:]], axis=4)

    qb = to_sub(q).reshape(B_, dil, H, nb, band, E)
    kb = band_keys(to_sub(k))
    vb = band_keys(to_sub(v))
    i = jnp.arange(band)[:, None]
    c = jnp.arange(2 * band)[None, :]
    dist_sub = band + i - c
    in_band = (dist_sub >= 0) & (dist_sub <= band)
    n = jnp.arange(nb)[:, None, None]
    mask = in_band[None] & ((n > 0) | (c[None] >= band))
    buckets = t5_bucket(jnp.clip(dist_sub, 0, band) * dil)
    bias = bias_tab.astype(jnp.float32)[buckets].transpose(2, 0, 1)
    s = jnp.einsum('bdhnqe,bdhnke->bdhnqk', qb, kb, preferred_element_type=jnp.float32) / math.sqrt(E)
    s = jnp.where(mask[None, None, None], s + bias[None, None, :, None], -1e30)
    m = jnp.max(s, axis=-1, keepdims=True)
    p = jnp.exp(s - m)
    den = jnp.sum(p, axis=-1, keepdims=True)
    o = jnp.einsum('bdhnqk,bdhnke->bdhnqe', p, vb.astype(jnp.float32)) / den
    lse = (m + jnp.log(den))[..., 0]
    o = o.reshape(B_, dil, H, Lp, E)[:, :, :, :L].transpose(0, 3, 1, 2, 4).reshape(B_, S_, H, E)
    lse = lse.reshape(B_, dil, H, Lp)[:, :, :, :L].transpose(0, 3, 1, 2).reshape(B_, S_, H)
    return o, lse


def dilated_attention(qkv, rel_bias):
    B_, S_ = qkv.shape[:2]
    outs, lses = [], []
    for g, (window, dil) in enumerate(DIL_PAIRS):
        hs = slice(g * DIL_HEADS_PER_GROUP, (g + 1) * DIL_HEADS_PER_GROUP)
        o, lse = dilated_group(qkv[:, :, 0, hs], qkv[:, :, 1, hs], qkv[:, :, 2, hs],
                               rel_bias[:, hs], window, dil)
        outs.append(o)
        lses.append(lse)
    o = jnp.stack(outs, axis=0)
    alpha = jax.nn.softmax(jnp.stack(lses, axis=0), axis=0)
    y = jnp.sum(alpha[..., None] * o, axis=0)
    return y.reshape(B_, S_, DIL_OUT_WIDTH).astype(qkv.dtype)


def stick_breaking_attention(qkv):
    B_, S_, _, H, E = qkv.shape
    nb = S_ // SB_BLOCK
    qh = qkv[:, :, 0].transpose(0, 2, 1, 3)
    kh = qkv[:, :, 1].transpose(0, 2, 1, 3)
    vh = qkv[:, :, 2].transpose(0, 2, 1, 3).astype(jnp.float32)
    qblk = qh.reshape(B_, H, nb, SB_BLOCK, E).transpose(2, 0, 1, 3, 4)
    key_pos = jnp.arange(S_)

    def one_block(args):
        qb, bi = args
        z = jnp.einsum('bhqe,bhke->bhqk', qb, kh, preferred_element_type=jnp.float32) / math.sqrt(E)
        q_pos = bi * SB_BLOCK + jnp.arange(SB_BLOCK)
        mask = key_pos[None, :] < q_pos[:, None]
        log_not = jnp.where(mask, jax.nn.log_sigmoid(-z), 0.0)
        excl = lax.cumsum(log_not, axis=3, reverse=True) - log_not
        w = jnp.where(mask, jnp.exp(jax.nn.log_sigmoid(z) + excl), 0.0)
        return jnp.einsum('bhqk,bhke->bhqe', w, vh)

    o = lax.map(one_block, (qblk, jnp.arange(nb)))
    return o.transpose(1, 0, 3, 2, 4).reshape(B_, S_, SB_WIDTH).astype(qkv.dtype)


def s5_mixer(u, a_re, a_im, log_dt, b_re, b_im, c_re, c_im, d_skip, w_glu):
    B_, S_, _ = u.shape
    f32 = jnp.float32
    uf = u.astype(f32).reshape(B_, S_, S5_GROUPS, S5_CH)
    lam = lax.complex(a_re.astype(f32), a_im.astype(f32))
    dt = jnp.exp(log_dt.astype(f32))[:, None]
    lam_bar = jnp.exp(lam * dt)
    b_t = lax.complex(b_re.astype(f32), b_im.astype(f32))
    b_bar = ((lam_bar - 1.0) / lam)[:, :, None] * b_t
    bu = jnp.einsum('gpc,bsgc->bsgp', b_bar, uf.astype(jnp.complex64))
    a = jnp.broadcast_to(lam_bar, (1, S_) + lam_bar.shape)

    def combine(left, right):
        a_l, b_l = left
        a_r, b_r = right
        return a_r * a_l, a_r * b_l + b_r

    _, h = lax.associative_scan(combine, (a, bu), axis=1)
    c_t = lax.complex(c_re.astype(f32), c_im.astype(f32))
    y = jnp.real(jnp.einsum('gcp,bsgp->bsgc', c_t, h)) + d_skip.astype(f32).reshape(S5_GROUPS, S5_CH) * uf
    y = jax.nn.gelu(y.reshape(B_, S_, S5_WIDTH))
    gl = y @ w_glu.astype(f32)
    y = gl[..., :S5_WIDTH] * jax.nn.sigmoid(gl[..., S5_WIDTH:])
    return y.astype(u.dtype)


def setup_inputs(seed: int = 0) -> dict:
    key = jax.random.key(seed)
    ks = jax.random.split(key, 22)
    nrm = jax.random.normal
    f32 = jnp.float32
    x = nrm(ks[0], (BATCH, SEQ, D_MODEL), f32)
    attn_norm_g = 1.0 + 0.02 * nrm(ks[1], (DEPTH, D_MODEL), f32)
    w_in = nrm(ks[2], (DEPTH, D_MODEL, IN_WIDTH), f32) * D_MODEL ** -0.5
    pool_w = nrm(ks[3], (DEPTH, len(POOL_WINDOWS), POOL_GROUP, POOL_GROUP), f32) * POOL_GROUP ** -0.5
    pool_scale = 1.0 + 0.02 * nrm(ks[4], (DEPTH, POOL_WIDTH), f32)
    rel_bias = 0.5 * nrm(ks[5], (REL_BUCKETS, DIL_HEADS), f32)
    s5_a_re = -0.5 + 0.01 * nrm(ks[6], (DEPTH, S5_GROUPS, S5_STATE), f32)
    s5_a_im = jnp.pi * jnp.arange(S5_STATE, dtype=f32)[None, None, :] + 0.01 * nrm(ks[7], (DEPTH, S5_GROUPS, S5_STATE), f32)
    s5_log_dt = jax.random.uniform(ks[8], (DEPTH, S5_GROUPS), f32, minval=math.log(1e-3), maxval=math.log(1e-1))
    s5_b_re = nrm(ks[9], (DEPTH, S5_GROUPS, S5_STATE, S5_CH), f32) * (2 * S5_CH) ** -0.5
    s5_b_im = nrm(ks[10], (DEPTH, S5_GROUPS, S5_STATE, S5_CH), f32) * (2 * S5_CH) ** -0.5
    s5_c_re = nrm(ks[11], (DEPTH, S5_GROUPS, S5_CH, S5_STATE), f32) * S5_STATE ** -0.5
    s5_c_im = nrm(ks[12], (DEPTH, S5_GROUPS, S5_CH, S5_STATE), f32) * S5_STATE ** -0.5
    s5_d = nrm(ks[13], (DEPTH, S5_WIDTH), f32)
    s5_w_glu = nrm(ks[14], (DEPTH, S5_WIDTH, 2 * S5_WIDTH), f32) * S5_WIDTH ** -0.5
    row_scale = jnp.concatenate([jnp.full((w,), w ** -0.5, f32) for w in BRANCH_WIDTHS])
    w_branch = nrm(ks[15], (DEPTH, BRANCH_WIDTH, D_MODEL), f32) * row_scale[None, :, None]
    w_gate = nrm(ks[16], (DEPTH, N_BRANCHES, D_MODEL, D_MODEL), f32) * D_MODEL ** -0.5
    w_out = nrm(ks[17], (DEPTH, D_MODEL, D_MODEL), f32) * D_MODEL ** -0.5
    ffn_norm_g = 1.0 + 0.02 * nrm(ks[18], (DEPTH, D_MODEL), f32)
    w_up = nrm(ks[19], (DEPTH, D_MODEL, 2 * FFN_HIDDEN), f32) * D_MODEL ** -0.5
    w_down = nrm(ks[20], (DEPTH, FFN_HIDDEN, D_MODEL), f32) * FFN_HIDDEN ** -0.5
    final_norm_g = 1.0 + 0.02 * nrm(ks[21], (D_MODEL,), f32)
    return {'x': x, 'attn_norm_g': attn_norm_g, 'w_in': w_in, 'pool_w': pool_w,
            'pool_scale': pool_scale, 'rel_bias': rel_bias, 's5_a_re': s5_a_re,
            's5_a_im': s5_a_im, 's5_log_dt': s5_log_dt, 's5_b_re': s5_b_re, 's5_b_im': s5_b_im,
            's5_c_re': s5_c_re, 's5_c_im': s5_c_im, 's5_d': s5_d, 's5_w_glu': s5_w_glu,
            'w_branch': w_branch, 'w_gate': w_gate, 'w_out': w_out, 'ffn_norm_g': ffn_norm_g,
            'w_up': w_up, 'w_down': w_down, 'final_norm_g': final_norm_g}


def reference(x, attn_norm_g, w_in, pool_w, pool_scale, rel_bias, s5_a_re, s5_a_im, s5_log_dt,
              s5_b_re, s5_b_im, s5_c_re, s5_c_im, s5_d, s5_w_glu, w_branch, w_gate, w_out,
              ffn_norm_g, w_up, w_down, final_norm_g):
    B_, S_, _ = x.shape
    o1 = POOL_WIDTH
    o2 = o1 + 3 * DIL_QKV_WIDTH
    o3 = o2 + 3 * SB_WIDTH
    for l in range(DEPTH):
        xn = rmsnorm(x, attn_norm_g[l])
        proj = xn @ w_in[l]
        u_pool = proj[..., :o1]
        qkv_dil = proj[..., o1:o2].reshape(B_, S_, 3, DIL_HEADS, DIL_HEAD_DIM)
        qkv_sb = proj[..., o2:o3].reshape(B_, S_, 3, SB_HEADS, SB_HEAD_DIM)
        u_s5 = proj[..., o3:]
        y_pool = pool_mixer(u_pool, pool_w[l], pool_scale[l])
        y_dil = dilated_attention(qkv_dil, rel_bias)
        y_sb = stick_breaking_attention(qkv_sb)
        y_s5 = s5_mixer(u_s5, s5_a_re[l], s5_a_im[l], s5_log_dt[l], s5_b_re[l], s5_b_im[l],
                        s5_c_re[l], s5_c_im[l], s5_d[l], s5_w_glu[l])
        merged = jnp.zeros_like(x)
        row = 0
        for bi, yb in enumerate((y_pool, y_dil, y_sb, y_s5)):
            width = BRANCH_WIDTHS[bi]
            gate = jax.nn.sigmoid(xn @ w_gate[l, bi])
            merged = merged + gate * (yb @ w_branch[l, row:row + width])
            row += width
        x = x + merged @ w_out[l]
        hn = rmsnorm(x, ffn_norm_g[l])
        gu = hn @ w_up[l]
        h = jax.nn.silu(gu[..., :FFN_HIDDEN]) * gu[..., FFN_HIDDEN:]
        x = x + h @ w_down[l]
    return rmsnorm(x, final_norm_g)
```

```cpp
#include <hip/hip_runtime.h>
#include <hip/hip_bf16.h>
#include <hip/hip_cooperative_groups.h>
#include <cstdio>
namespace cg = cooperative_groups;

#ifndef ONE_LAUNCH
#define ONE_LAUNCH 1
#endif

typedef unsigned short u16;
using bf16x8 = __attribute__((ext_vector_type(8))) short;
using s16x4  = __attribute__((ext_vector_type(4))) short;
using f32x4  = __attribute__((ext_vector_type(4))) float;
using f32x16 = __attribute__((ext_vector_type(16))) float;
using u32x4  = __attribute__((ext_vector_type(4))) unsigned;
typedef __bf16 bf2_t __attribute__((ext_vector_type(2)));
typedef float f2_t __attribute__((ext_vector_type(2)));
#define DI __device__ __forceinline__
#define LAS __attribute__((address_space(3)))

constexpr int DM = 1024, BATCH = 8, SEQ = 4096, TOK = BATCH * SEQ, DEPTH = 4;
constexpr int INW = 4864, O1 = 512, O2 = 2816, O3 = 4352;
constexpr int FFN = 2816;
constexpr int NTHR = 512;
constexpr int LDS_BYTES = 147456;
constexpr int PH_PER_LAYER = 9, N_PHASES = DEPTH * PH_PER_LAYER + 1;

constexpr size_t WS_PROJ = 0;
constexpr size_t WS_XN   = WS_PROJ + (size_t)TOK * INW * 2;
constexpr size_t WS_PB   = WS_XN + (size_t)TOK * DM * 2;
constexpr size_t WS_MG   = WS_PB + (size_t)TOK * 512 * 2;
constexpr size_t WS_LSE  = WS_MG + (size_t)TOK * DM * 2;
constexpr size_t WS_WIN  = WS_LSE + (size_t)TOK * 12 * 4;
constexpr size_t WS_WG   = WS_WIN + (size_t)INW * DM * 2;
constexpr size_t WS_WB   = WS_WG + (size_t)4 * DM * DM * 2;
constexpr size_t WS_WO   = WS_WB + (size_t)DM * 1792 * 2;
constexpr size_t WS_WUP  = WS_WO + (size_t)DM * DM * 2;
constexpr size_t WS_WDN  = WS_WUP + (size_t)2 * FFN * DM * 2;
constexpr size_t WS_WGLU = WS_WDN + (size_t)DM * FFN * 2;
constexpr size_t WS_BAR  = WS_WGLU + (size_t)DM * 512 * 2;
constexpr size_t WS_END  = WS_BAR + 16384;

struct Params {
  const float* in[22];
  float* out;
  char* ws;
  int ph_lo, ph_hi;
};
typedef const Params __attribute__((address_space(4)))* CP;

DI unsigned pack2(float a, float b) { f2_t v = {a, b}; bf2_t r = __builtin_convertvector(v, bf2_t); return __builtin_bit_cast(unsigned, r); }
DI u16 f2bf(float a) { return (u16)(pack2(a, 0.f) & 0xffffu); }
DI float bf2f(u16 v) { return __uint_as_float(((unsigned)v) << 16); }
DI float bflo(unsigned v) { return __uint_as_float(v << 16); }
DI float bfhi(unsigned v) { return __uint_as_float(v & 0xffff0000u); }
DI void store4bf(u16* p, f32x4 a) { uint2 v; v.x = pack2(a[0], a[1]); v.y = pack2(a[2], a[3]); *(uint2*)p = v; }
DI f32x4 load4bf(const u16* p) { uint2 v = *(const uint2*)p; f32x4 r = {bflo(v.x), bfhi(v.x), bflo(v.y), bfhi(v.y)}; return r; }
DI float fexp2(float x) { return __builtin_amdgcn_exp2f(x); }
DI float flog2(float x) { return __builtin_amdgcn_logf(x); }
DI float frcp(float x) { return __builtin_amdgcn_rcpf(x); }
DI float sigmoidf_(float x) { return frcp(1.f + fexp2(-1.44269504089f * x)); }
DI float siluf_(float x) { return x * sigmoidf_(x); }
DI float gelu_tanh(float x) {
  float u = 0.7978845608028654f * (x + 0.044715f * x * x * x);
  float e = fexp2(2.885390081777927f * u);
  float th = 1.f - 2.f * frcp(1.f + e);
  return 0.5f * x * (1.f + th);
}
DI int get_tid(int wv) { int l; asm volatile("v_mbcnt_lo_u32_b32 %0, -1, 0\n\tv_mbcnt_hi_u32_b32 %0, -1, %0" : "=v"(l)); return wv * 64 + l; }
DI int get_bid() { int b = blockIdx.x; asm volatile("" : "+s"(b)); return b; }
DI int get_grid() { int g = gridDim.x; asm volatile("" : "+s"(g)); return g; }
DI int wave_of(int tid) { return __builtin_amdgcn_readfirstlane(tid >> 6); }
#define WVP const int WV,
DI float shflx(float v, int mask, int lane) { return __int_as_float(__builtin_amdgcn_ds_bpermute((lane ^ mask) << 2, __float_as_int(v))); }
DI int crow(int i, int h) { return (i & 3) + 8 * (i >> 2) + 4 * h; }
#define MFMA32(a, b, c) __builtin_amdgcn_mfma_f32_32x32x16_bf16((a), (b), (c), 0, 0, 0)
#define MFMA16(a, b, c) __builtin_amdgcn_mfma_f32_16x16x32_bf16((a), (b), (c), 0, 0, 0)
DI s16x4 tr_read(const char* p) { return __builtin_amdgcn_ds_read_tr16_b64_v4i16((LAS s16x4*)p); }
DI bf16x8 packP(const f32x16& x, int s) {
  unsigned a = pack2(x[8 * s], x[8 * s + 1]), b = pack2(x[8 * s + 2], x[8 * s + 3]);
  unsigned c = pack2(x[8 * s + 4], x[8 * s + 5]), d = pack2(x[8 * s + 6], x[8 * s + 7]);
  uint4 v = {a, b, c, d};
  return __builtin_bit_cast(bf16x8, v);
}

constexpr int BK = 64, HALF = 128, HT = HALF * BK;
DI int lds_byte(int r, int c) {
  int st = (r >> 4) * 2 + (c >> 5), rr = r & 15, cc = c & 31, ob = rr * 64 + cc * 2;
  return st * 1024 + (ob ^ (((ob >> 9) & 1) << 5));
}
DI void stage_rc(int b, int& R, int& C) {
  int st = b / 1024, sb = b % 1024, swz = sb ^ (((sb >> 9) & 1) << 5);
  R = (st >> 1) * 16 + swz / 64; C = (st & 1) * 32 + (swz % 64) / 2;
}

typedef f32x4 AccT[2][2][4][2];
DI void gemm_core(WVP char* smem, const u16* __restrict__ A, int lda, int ar0, int ar1,
                  const u16* __restrict__ B, int ldb, int bc0, int K, AccT& acc) {
  u16* shm = (u16*)smem;
#define SA(b, h) (shm + ((b) * 2 + (h)) * HT)
#define SB(b, h) (shm + (4 + (b) * 2 + (h)) * HT)
#define STAGE_A(P, br, kt) do { const char* _g = (const char*)(A + (long)(br) * lda + (long)(kt) * BK); \
    __builtin_amdgcn_global_load_lds((const unsigned*)(_g + (size_t)offA0), (unsigned*)((char*)(P) + sb0), 16, 0, 0); \
    __builtin_amdgcn_global_load_lds((const unsigned*)(_g + (size_t)lda * 128 + (size_t)offA0), (unsigned*)((char*)(P) + sb1), 16, 0, 0); } while (0)
#define STAGE_B(P, br, kt) do { const char* _g = (const char*)(B + (long)(br) * ldb + (long)(kt) * BK); \
    __builtin_amdgcn_global_load_lds((const unsigned*)(_g + (size_t)offB0), (unsigned*)((char*)(P) + sb0), 16, 0, 0); \
    __builtin_amdgcn_global_load_lds((const unsigned*)(_g + (size_t)ldb * 128 + (size_t)offB0), (unsigned*)((char*)(P) + sb1), 16, 0, 0); } while (0)
#define LDA(dst, b, h) for (int m = 0; m < 4; ++m) for (int k = 0; k < 2; ++k) \
    dst[m][k] = *reinterpret_cast<const bf16x8*>((char*)SA(b, h) + lds_byte(wr * 64 + m * 16 + fr, k * 32 + fq * 8))
#define LDB(dst, b, h) for (int n = 0; n < 2; ++n) for (int k = 0; k < 2; ++k) \
    dst[n][k] = *reinterpret_cast<const bf16x8*>((char*)SB(b, h) + lds_byte(wc * 32 + n * 16 + fr, k * 32 + fq * 8))
#define MMA(ai, bj, At_, Bt_) do { __builtin_amdgcn_s_setprio(1); \
    for (int m = 0; m < 4; ++m) for (int n = 0; n < 2; ++n) for (int k = 0; k < 2; ++k) \
      acc[ai][bj][m][n] = MFMA16(At_[m][k], Bt_[n][k], acc[ai][bj][m][n]); \
    __builtin_amdgcn_s_setprio(0); } while (0)
#define WAIT_V(n) asm volatile("s_waitcnt vmcnt(" #n ")" ::: "memory")
#define WAIT_L(n) asm volatile("s_waitcnt lgkmcnt(" #n ")" ::: "memory")
#define BAR __builtin_amdgcn_s_barrier()
#define SCHED __builtin_amdgcn_sched_barrier(0)

  const int tid = get_tid(WV);
  const int wid = wave_of(tid), lane = tid & 63, wr = wid >> 2, wc = wid & 3, fr = lane & 15, fq = lane >> 4;
  const int sb0 = tid * 16, sb1 = sb0 + 8192;
  int R0, C0; stage_rc(sb0, R0, C0);
  const unsigned offA0 = (unsigned)(R0 * lda + C0) * 2u, offB0 = (unsigned)(R0 * ldb + C0) * 2u;
  const int ac0 = ar0, ac1 = ar1, bb0 = bc0, bb1 = bc0 + HALF;
  bf16x8 At[4][2], B0[2][2], B1[2][2];
  const int nt = K / BK;
  __syncthreads();
  STAGE_B(SB(0, 0), bb0, 0); STAGE_A(SA(0, 0), ac0, 0);
  STAGE_B(SB(0, 1), bb1, 0); STAGE_A(SA(0, 1), ac1, 0);
  if (wr == 1) BAR;
  WAIT_V(4); BAR;
  STAGE_B(SB(1, 0), bb0, 1); STAGE_A(SA(1, 0), ac0, 1); STAGE_B(SB(1, 1), bb1, 1);
  WAIT_V(6); BAR;
  for (int t = 0; t < nt - 2; t += 2) {
    LDB(B0, 0, 0); SCHED; LDA(At, 0, 0); STAGE_A(SA(1, 1), ac1, t + 1);
    WAIT_L(8); BAR; WAIT_L(0); MMA(0, 0, At, B0); BAR; SCHED;
    LDB(B1, 0, 1); STAGE_B(SB(0, 0), bb0, t + 2);
    BAR; WAIT_L(0); MMA(0, 1, At, B1); BAR;
    LDA(At, 0, 1); STAGE_A(SA(0, 0), ac0, t + 2);
    BAR; WAIT_L(0); MMA(1, 0, At, B0); BAR; SCHED;
    STAGE_B(SB(0, 1), bb1, t + 2);
    WAIT_V(6); BAR; MMA(1, 1, At, B1); BAR;
    LDB(B0, 1, 0); SCHED; LDA(At, 1, 0); STAGE_A(SA(0, 1), ac1, t + 2);
    WAIT_L(8); BAR; WAIT_L(0); MMA(0, 0, At, B0); BAR; SCHED;
    LDB(B1, 1, 1); STAGE_B(SB(1, 0), bb0, t + 3);
    BAR; WAIT_L(0); MMA(0, 1, At, B1); BAR;
    LDA(At, 1, 1); STAGE_A(SA(1, 0), ac0, t + 3);
    BAR; WAIT_L(0); MMA(1, 0, At, B0); BAR; SCHED;
    STAGE_B(SB(1, 1), bb1, t + 3);
    WAIT_V(6); BAR; MMA(1, 1, At, B1); BAR;
  }
  { LDB(B0, 0, 0); LDA(At, 0, 0); STAGE_A(SA(1, 1), ac1, nt - 1);
    BAR; WAIT_L(0); MMA(0, 0, At, B0); BAR;
    LDB(B1, 0, 1); BAR; WAIT_L(0); MMA(0, 1, At, B1); BAR;
    LDA(At, 0, 1); WAIT_V(4); BAR; WAIT_L(0); MMA(1, 0, At, B0); MMA(1, 1, At, B1); BAR; }
  { LDB(B0, 1, 0); LDA(At, 1, 0); WAIT_V(2); BAR; WAIT_L(0); MMA(0, 0, At, B0); BAR;
    LDB(B1, 1, 1); WAIT_V(0); BAR; WAIT_L(0); MMA(0, 1, At, B1); BAR;
    LDA(At, 1, 1); BAR; WAIT_L(0); MMA(1, 0, At, B0); MMA(1, 1, At, B1); BAR; }
  if (wr == 0) BAR;
#undef SA
#undef SB
}
template <class Epi>
DI void apply_epi(WVP AccT& acc, int bc0, const Epi& epi) {
  const int t2 = get_tid(WV);
  const int wid2 = wave_of(t2), lane2 = t2 & 63, wr2 = wid2 >> 2, wc2 = wid2 & 3, fr2 = lane2 & 15, fq2 = lane2 >> 4;
  for (int bj = 0; bj < 2; ++bj) for (int m = 0; m < 4; ++m) {
    for (int n = 0; n < 2; ++n)
      epi(acc[0][bj][m][n], acc[1][bj][m][n], wr2 * 64 + m * 16 + fq2 * 4, bc0 + bj * HALF + wc2 * 32 + n * 16 + fr2, bj * 8 + m * 2 + n, t2);
    if (m & 1) __builtin_amdgcn_sched_barrier(0);
  }
}
template <class Epi>
DI void apply_epi_staged(WVP char* smem, AccT& acc, int bc0, const Epi& epi) {
  constexpr int NC = Epi::NC, PITCH = NC * 2 + 16;
  const int t2 = get_tid(WV);
  const int wid2 = wave_of(t2), lane2 = t2 & 63, wr2 = wid2 >> 2, wc2 = wid2 & 3, fr2 = lane2 & 15, fq2 = lane2 >> 4;
  for (int bj = 0; bj < 2; ++bj) for (int m = 0; m < 4; ++m) {
    for (int n = 0; n < 2; ++n) {
      const int rl = wr2 * 64 + m * 16 + fq2 * 4, tc = bj * HALF + wc2 * 32 + n * 16 + fr2;
      f32x4 r0, r1;
      epi.tr(acc[0][bj][m][n], acc[1][bj][m][n], rl, bc0 + tc, bj * 8 + m * 2 + n, t2, r0, r1);
      uint2 v0; v0.x = pack2(r0[0], r0[1]); v0.y = pack2(r0[2], r0[3]);
      *(uint2*)(smem + tc * PITCH + rl * 2) = v0;
      if (NC == 256) { uint2 v1; v1.x = pack2(r1[0], r1[1]); v1.y = pack2(r1[2], r1[3]); *(uint2*)(smem + tc * PITCH + (HALF + rl) * 2) = v1; }
    }
    if (m & 1) __builtin_amdgcn_sched_barrier(0);
  }
  __syncthreads();
  constexpr int CPR = NC / 8;
#pragma unroll
  for (int i = 0; i < 256 * CPR / NTHR; ++i) {
    const int L = i * NTHR + t2, row = L / CPR, ch = L % CPR;
    const u32x4 v = *(const u32x4*)(smem + row * PITCH + ch * 16);
    *(u32x4*)(epi.out(bc0 + row, ch)) = v;
  }
}
template <class Epi>
DI void gemm_tile(WVP char* smem, const u16* __restrict__ A, int lda, int ar0, int ar1,
                  const u16* __restrict__ B, int ldb, int bc0, int K, const Epi& epi) {
  AccT acc = {};
  gemm_core(WV, smem, A, lda, ar0, ar1, B, ldb, bc0, K, acc);
  apply_epi(WV, acc, bc0, epi);
}
template <class Epi>
DI void gemm_tile_staged(WVP char* smem, const u16* __restrict__ A, int lda, int ar0, int ar1,
                  const u16* __restrict__ B, int ldb, int bc0, int K, const Epi& epi) {
  AccT acc = {};
  gemm_core(WV, smem, A, lda, ar0, ar1, B, ldb, bc0, K, acc);
  apply_epi_staged(WV, smem, acc, bc0, epi);
}

DI void tile_map(int id, int nwg, int nR, int nC, int& pr, int& pc) {
  constexpr int NX = 8, WGM = 4;
  int q = nwg / NX, r = nwg % NX, xcd = id % NX, off = id / NX;
  id = (xcd < r ? xcd * (q + 1) : r * (q + 1) + (xcd - r) * q) + off;
  int nig = WGM * nC, gid = id / nig, fm = gid * WGM, gsz = min(nR - fm, WGM);
  pr = fm + ((id % nig) % gsz); pc = (id % nig) / gsz;
}

struct EpiStore2 { static constexpr int NC = 256; u16* dst; int ld; int n0, n1;
  DI void tr(const f32x4& a0, const f32x4& a1, int, int, int, int, f32x4& r0, f32x4& r1) const { r0 = a0; r1 = a1; }
  DI u16* out(int row, int ch) const { return dst + (long)row * ld + (ch < 16 ? n0 + ch * 8 : n1 + (ch - 16) * 8); } };
template <int ACT> struct EpiGated { static constexpr int NC = 128; u16* dst; int ld; int nb;
  DI void tr(const f32x4& a0, const f32x4& a1, int, int, int, int, f32x4& r0, f32x4& r1) const {
    for (int j = 0; j < 4; ++j) r0[j] = ACT == 0 ? siluf_(a0[j]) * a1[j] : a0[j] * sigmoidf_(a1[j]);
    r1 = r0; }
  DI u16* out(int row, int ch) const { return dst + (long)row * ld + nb + ch * 8; } };
struct EpiResid { const float* xin; float* xout; int n0, n1;
  DI void operator()(f32x4& a0, f32x4& a1, int rl, int col, int, int) const {
    f32x4 v0 = *(const f32x4*)(xin + (long)col * DM + n0 + rl), v1 = *(const f32x4*)(xin + (long)col * DM + n1 + rl);
    *(f32x4*)(xout + (long)col * DM + n0 + rl) = v0 + a0; *(f32x4*)(xout + (long)col * DM + n1 + rl) = v1 + a1; } };
DI u16* stash_ptr(u16* base, int ld, int bc0, int j, int tid) { const int L = j * NTHR + tid; return base + (long)(bc0 + (L >> 5)) * ld + (L & 31) * 8; }
DI void unpack8(const u32x4& v, f32x4& lo, f32x4& hi) { lo = f32x4{bflo(v[0]), bfhi(v[0]), bflo(v[1]), bfhi(v[1])}; hi = f32x4{bflo(v[2]), bfhi(v[2]), bflo(v[3]), bfhi(v[3])}; }
struct EpiSig { u16* dst; int ld; int bc0;
  DI void operator()(f32x4& a0, f32x4& a1, int, int, int j, int tid) const {
    f32x4 r0, r1;
    for (int q = 0; q < 4; ++q) { r0[q] = fmaxf(sigmoidf_(a0[q]), 1e-20f); r1[q] = fmaxf(sigmoidf_(a1[q]), 1e-20f); }
    u32x4 v = {pack2(r0[0], r0[1]), pack2(r0[2], r0[3]), pack2(r1[0], r1[1]), pack2(r1[2], r1[3])};
    *(u32x4*)stash_ptr(dst, ld, bc0, j, tid) = v; } };
struct EpiRescale { u16* sc; int ldc; u16* sn; int ldn; int bc0;
  DI void operator()(f32x4& a0, f32x4& a1, int, int, int j, int tid) const {
    const u32x4 vc = *(const u32x4*)stash_ptr(sc, ldc, bc0, j, tid), vn = *(const u32x4*)stash_ptr(sn, ldn, bc0, j, tid);
    f32x4 c0, c1, n0, n1; unpack8(vc, c0, c1); unpack8(vn, n0, n1);
    for (int q = 0; q < 4; ++q) { a0[q] *= c0[q] * frcp(n0[q]); a1[q] *= c1[q] * frcp(n1[q]); } } };
struct EpiFinalGate { static constexpr int NC = 256; u16* mg; int nbase; int bc0;
  DI void tr(const f32x4& a0, const f32x4& a1, int, int, int j, int tid, f32x4& r0, f32x4& r1) const {
    const u32x4 vc = *(const u32x4*)stash_ptr(mg + nbase, DM, bc0, j, tid);
    f32x4 c0, c1; unpack8(vc, c0, c1); r0 = a0 * c0; r1 = a1 * c1; }
  DI u16* out(int row, int ch) const { return mg + (long)row * DM + nbase + ch * 8; } };

DI void phase_rmsnorm(WVP const float* __restrict__ x, const float* __restrict__ g, u16* __restrict__ o) {
  const int BID = get_bid(), GRD = get_grid();
  const int tid = get_tid(WV), wave = wave_of(tid), lane = tid & 63;
  f32x4 gv[4];
  for (int i = 0; i < 4; ++i) gv[i] = *(const f32x4*)(g + i * 256 + lane * 4);
  for (int row = BID * 8 + wave; row < TOK; row += GRD * 8) {
    f32x4 v[4]; float ss = 0.f;
    for (int i = 0; i < 4; ++i) { v[i] = *(const f32x4*)(x + (long)row * DM + i * 256 + lane * 4); ss += v[i][0] * v[i][0] + v[i][1] * v[i][1] + v[i][2] * v[i][2] + v[i][3] * v[i][3]; }
    for (int d = 32; d >= 1; d >>= 1) ss += shflx(ss, d, lane);
    float rs = rsqrtf(ss * (1.f / DM) + 1e-6f);
    for (int i = 0; i < 4; ++i) store4bf(o + (long)row * DM + i * 256 + lane * 4, v[i] * rs * gv[i]);
  }
}
DI void phase_final_norm(WVP float* __restrict__ x, const float* __restrict__ g) {
  const int BID = get_bid(), GRD = get_grid();
  const int tid = get_tid(WV), wave = wave_of(tid), lane = tid & 63;
  f32x4 gv[4];
  for (int i = 0; i < 4; ++i) gv[i] = *(const f32x4*)(g + i * 256 + lane * 4);
  for (int row = BID * 8 + wave; row < TOK; row += GRD * 8) {
    f32x4 v[4]; float ss = 0.f;
    for (int i = 0; i < 4; ++i) { v[i] = *(const f32x4*)(x + (long)row * DM + i * 256 + lane * 4); ss += v[i][0] * v[i][0] + v[i][1] * v[i][1] + v[i][2] * v[i][2] + v[i][3] * v[i][3]; }
    for (int d = 32; d >= 1; d >>= 1) ss += shflx(ss, d, lane);
    float rs = rsqrtf(ss * (1.f / DM) + 1e-6f);
    for (int i = 0; i < 4; ++i) *(f32x4*)(x + (long)row * DM + i * 256 + lane * 4) = v[i] * rs * gv[i];
  }
}

DI void transpose_tile(WVP float* sm, const float* __restrict__ src, int lds_, u16* __restrict__ dst, int ldd, int k0, int n0) {
  const int tid = get_tid(WV);
  constexpr int P = 257;
  f32x4 v[8];
  const int rb = tid >> 6, c4 = (tid & 63) * 4;
#pragma unroll
  for (int i = 0; i < 8; ++i) v[i] = *(const f32x4*)(src + (long)(k0 + rb + 8 * i) * lds_ + n0 + c4);
  __syncthreads();
#pragma unroll
  for (int i = 0; i < 8; ++i) for (int j = 0; j < 4; ++j) sm[(rb + 8 * i) * P + c4 + j] = v[i][j];
  __syncthreads();
#pragma unroll
  for (int i = 0; i < 4; ++i) {
    const int c = tid + NTHR * i, n = c >> 3, k8 = (c & 7) * 8;
    u32x4 o;
    o[0] = pack2(sm[(k8 + 0) * P + n], sm[(k8 + 1) * P + n]); o[1] = pack2(sm[(k8 + 2) * P + n], sm[(k8 + 3) * P + n]);
    o[2] = pack2(sm[(k8 + 4) * P + n], sm[(k8 + 5) * P + n]); o[3] = pack2(sm[(k8 + 6) * P + n], sm[(k8 + 7) * P + n]);
    *(u32x4*)(dst + (long)(n0 + n) * ldd + k0 + k8) = o;
  }
}
DI void phase_wprep(WVP CP pp, int l, char* smem) {
  const int BID = get_bid(), GRD = get_grid();
  char* ws = pp->ws;
  float* sm = (float*)smem;
  const float* w_in = pp->in[2] + (size_t)l * DM * INW;
  const float* w_gate = pp->in[16] + (size_t)l * 4 * DM * DM;
  const float* w_branch = pp->in[15] + (size_t)l * 1792 * DM;
  const float* w_out = pp->in[17] + (size_t)l * DM * DM;
  const float* w_up = pp->in[19] + (size_t)l * DM * 2 * FFN;
  const float* w_down = pp->in[20] + (size_t)l * FFN * DM;
  const float* w_glu = pp->in[14] + (size_t)l * 512 * 1024;
  u16* WB = (u16*)(ws + WS_WB);
  constexpr int NJ = 12;
  const float* src[NJ] = {w_in, w_gate, w_gate + DM * DM, w_gate + 2 * DM * DM, w_gate + 3 * DM * DM,
                          w_branch + 512 * DM, w_branch + 768 * DM, w_branch + 1280 * DM, w_out, w_up, w_down, w_glu};
  const int lds_[NJ] = {INW, DM, DM, DM, DM, DM, DM, DM, DM, 2 * FFN, DM, 1024};
  const int Kd[NJ] = {DM, DM, DM, DM, DM, 256, 512, 512, DM, DM, FFN, 512};
  const int Nd[NJ] = {INW, DM, DM, DM, DM, DM, DM, DM, DM, 2 * FFN, DM, 1024};
  u16* dst[NJ] = {(u16*)(ws + WS_WIN), (u16*)(ws + WS_WG), (u16*)(ws + WS_WG) + DM * DM, (u16*)(ws + WS_WG) + 2 * DM * DM, (u16*)(ws + WS_WG) + 3 * DM * DM,
                  WB + DM * 512, WB + DM * 768, WB + DM * 1280, (u16*)(ws + WS_WO), (u16*)(ws + WS_WUP), (u16*)(ws + WS_WDN), (u16*)(ws + WS_WGLU)};
  int base = 0;
#pragma unroll
  for (int j = 0; j < NJ; ++j) {
    int nk = Kd[j] / 64, nn = Nd[j] / 256, cnt = nk * nn;
    int first = (BID - base % GRD + GRD) % GRD;
    for (int i = first; i < cnt; i += GRD) transpose_tile(WV, sm, src[j], lds_[j], dst[j], Kd[j], (i / nn) * 64, (i % nn) * 256);
    base += cnt;
  }
  const float* pool_w = pp->in[3] + (size_t)l * 4 * 128 * 128;
  const float* pool_s = pp->in[4] + (size_t)l * 512;
  for (int it = GRD - 1 - BID; it < 16 * 16; it += GRD) {
    const int k0 = (it >> 4) * 32, n0 = (it & 15) * 64;
    const int tid = get_tid(WV);
    const int n = n0 + (tid & 63), kb = k0 + (tid >> 6) * 4, g = kb >> 7;
    float accv[4] = {0, 0, 0, 0};
    const float* pw = pool_w + (size_t)(g * 128 + (kb & 127)) * 128;
#pragma unroll 2
    for (int d = 0; d < 128; d += 4) {
      const f32x4 ps = *(const f32x4*)(pool_s + g * 128 + d);
      float wv[4];
      for (int q = 0; q < 4; ++q) wv[q] = ps[q] * w_branch[(long)(g * 128 + d + q) * DM + n];
      for (int jj = 0; jj < 4; ++jj) {
        const f32x4 p4 = *(const f32x4*)(pw + jj * 128 + d);
        accv[jj] += p4[0] * wv[0] + p4[1] * wv[1] + p4[2] * wv[2] + p4[3] * wv[3];
      }
    }
    uint2 o; o.x = pack2(accv[0], accv[1]); o.y = pack2(accv[2], accv[3]);
    *(uint2*)(WB + (long)n * 512 + kb) = o;
  }
}

DI void mix_pool(WVP const u16* __restrict__ proj, u16* __restrict__ pb) {
  const int BID = get_bid(), GRD = get_grid();
  const int tid = get_tid(WV);
  for (int idx = BID * NTHR + tid; idx < (TOK / 16) * 64; idx += GRD * NTHR) {
    const int cc = idx & 63, t0 = (idx >> 6) * 16, gi = cc >> 4, w = 2 << gi, s0 = t0 & (SEQ - 1);
    const u16* base = proj + (long)t0 * INW + cc * 8;
    float a[8] = {0, 0, 0, 0, 0, 0, 0, 0};
    for (int i = 1; i < w; ++i) {
      if (s0 - i >= 0) {
        const u32x4 v = *(const u32x4*)(base - (long)i * INW);
        a[0] += bflo(v[0]); a[1] += bfhi(v[0]); a[2] += bflo(v[1]); a[3] += bfhi(v[1]); a[4] += bflo(v[2]); a[5] += bfhi(v[2]); a[6] += bflo(v[3]); a[7] += bfhi(v[3]);
      }
    }
#pragma unroll 4
    for (int k = 0; k < 16; ++k) {
      const int s = s0 + k;
      const u32x4 v = *(const u32x4*)(base + (long)k * INW);
      float u[8] = {bflo(v[0]), bfhi(v[0]), bflo(v[1]), bfhi(v[1]), bflo(v[2]), bfhi(v[2]), bflo(v[3]), bfhi(v[3])};
      for (int q = 0; q < 8; ++q) a[q] += u[q];
      const float ic = 1.f / (float)min(w, s + 1);
      u32x4 o;
      o[0] = pack2(a[0] * ic - u[0], a[1] * ic - u[1]); o[1] = pack2(a[2] * ic - u[2], a[3] * ic - u[3]);
      o[2] = pack2(a[4] * ic - u[4], a[5] * ic - u[5]); o[3] = pack2(a[6] * ic - u[6], a[7] * ic - u[7]);
      *(u32x4*)(pb + (long)(t0 + k) * 512 + cc * 8) = o;
      if (s - w + 1 >= 0) {
        const u32x4 x = *(const u32x4*)(base + (long)(k - w + 1) * INW);
        a[0] -= bflo(x[0]); a[1] -= bfhi(x[0]); a[2] -= bflo(x[1]); a[3] -= bfhi(x[1]); a[4] -= bflo(x[2]); a[5] -= bfhi(x[2]); a[6] -= bflo(x[3]); a[7] -= bfhi(x[3]);
      }
    }
  }
}

DI int t5_bucket(int dist) {
  if (dist < 16) return dist;
  const int thr[15] = {22, 30, 40, 54, 73, 99, 134, 182, 246, 332, 450, 609, 825, 1117, 1513};
  int b = 16;
#pragma unroll
  for (int k = 0; k < 15; ++k) b += (dist >= thr[k]) ? 1 : 0;
  return b;
}
DI void mix_dil(WVP u16* __restrict__ proj, float* __restrict__ lse, const float* __restrict__ rel_bias, char* smem) {
  const int BID = get_bid(), GRD = get_grid();
  const int tid = get_tid(WV), wave = wave_of(tid), lane = tid & 63, h = lane >> 5, l31 = lane & 31;
  float* btab = (float*)smem;
  char* vbuf = smem + 12 * 132 * 4 + wave * 4608;
  __syncthreads();
  for (int i = tid; i < 12 * 129; i += NTHR) {
    int H = i / 129, ds = i % 129, g = H >> 2; int dil = g == 0 ? 1 : (g == 1 ? 4 : 16);
    btab[H * 132 + ds] = rel_bias[t5_bucket(ds * dil) * 12 + H] * 1.44269504089f;
  }
  __syncthreads();
  const float sc = 1.44269504089f * 0.125f;
  const int i16 = lane & 15, tq = i16 >> 2, tp = i16 & 3, blk = (lane >> 4) & 1;
#define DIL_DECODE(u_, tb_, q0_, H_, dil_, j0_) \
    const int v_ = (u_) & 127, hh_ = ((u_) >> 7) & 3, g_ = ((u_) >> 9) % 3, b_ = (u_) / (512 * 3); \
    const int dsh_ = g_ * 2; dil_ = 1 << dsh_; const int nq_ = (SEQ >> dsh_) >> 5; \
    const int r_ = v_ / nq_; q0_ = (v_ % nq_) * 32; H_ = g_ * 4 + hh_; tb_ = (long)b_ * SEQ + r_; j0_ = q0_ >= 128 ? 0 : (128 - q0_) >> 5;
  bf16x8 bq_n[4], ak_n[4]; u32x4 vv_n[4];
  const int u_first = BID * 8 + wave, u_step = GRD * 8, u_end = BATCH * 3 * 4 * 128;
  if (u_first < u_end) {
    long tb; int q0, H, dil, j0; DIL_DECODE(u_first, tb, q0, H, dil, j0)
    const u16* qp = proj + (tb + (long)(q0 + l31) * dil) * INW + O1 + H * 64;
    for (int s = 0; s < 4; ++s) bq_n[s] = *(const bf16x8*)(qp + 16 * s + 8 * h);
    const u16* kp = proj + (tb + (long)(q0 - 128 + 32 * j0 + l31) * dil) * INW + O1 + 768 + H * 64;
    for (int s = 0; s < 4; ++s) ak_n[s] = *(const bf16x8*)(kp + 16 * s + 8 * h);
    for (int c = 0; c < 4; ++c) vv_n[c] = *(const u32x4*)(kp + 768 + h * 32 + c * 8);
  }
#pragma nounroll
  for (int u = u_first; u < u_end; u += u_step) {
    long tbase; int q0, H, dil, j0; DIL_DECODE(u, tbase, q0, H, dil, j0)
    u16* qp = proj + (tbase + (long)(q0 + l31) * dil) * INW + O1 + H * 64;
    bf16x8 bq[4];
    for (int s = 0; s < 4; ++s) bq[s] = bq_n[s];
    f32x16 O[2]; for (int e = 0; e < 2; ++e) for (int i = 0; i < 16; ++i) O[e][i] = 0.f;
    float mrun = -1e30f, lsum = 0.f;
    const float* bt = btab + H * 132;
    const u16* kbase_ = proj + tbase * INW + O1 + 768 + H * 64;
    f32x16 sacc; for (int i = 0; i < 16; ++i) sacc[i] = 0.f;
    for (int s = 0; s < 4; ++s) sacc = MFMA32(ak_n[s], bq[s], sacc);
    u32x4 vv[4];
    for (int c = 0; c < 4; ++c) vv[c] = vv_n[c];
    if (j0 + 1 < 5) {
      const u16* kp = kbase_ + (long)(q0 - 128 + 32 * (j0 + 1) + l31) * dil * INW;
      for (int s = 0; s < 4; ++s) ak_n[s] = *(const bf16x8*)(kp + 16 * s + 8 * h);
      for (int c = 0; c < 4; ++c) vv_n[c] = *(const u32x4*)(kp + 768 + h * 32 + c * 8);
    }
#pragma nounroll
    for (int j = j0; j < 5; ++j) {
      const int kb = q0 - 128 + 32 * j;
      for (int c = 0; c < 4; ++c) *(u32x4*)(vbuf + l31 * 144 + h * 64 + c * 16) = vv[c];
      f32x16 snx; for (int i = 0; i < 16; ++i) snx[i] = 0.f;
      if (j + 1 < 5) {
        for (int s = 0; s < 4; ++s) snx = MFMA32(ak_n[s], bq[s], snx);
        for (int c = 0; c < 4; ++c) vv[c] = vv_n[c];
        if (j + 2 < 5) {
          const u16* kp = kbase_ + (long)(kb + 64 + l31) * dil * INW;
          for (int s = 0; s < 4; ++s) ak_n[s] = *(const bf16x8*)(kp + 16 * s + 8 * h);
          for (int c = 0; c < 4; ++c) vv_n[c] = *(const u32x4*)(kp + 768 + h * 32 + c * 8);
        }
      }
      if (j == 4 && u + u_step < u_end) {
        long tb2; int q02, H2, dil2, j02; DIL_DECODE(u + u_step, tb2, q02, H2, dil2, j02)
        const u16* qp2 = proj + (tb2 + (long)(q02 + l31) * dil2) * INW + O1 + H2 * 64;
        for (int s = 0; s < 4; ++s) bq_n[s] = *(const bf16x8*)(qp2 + 16 * s + 8 * h);
        const u16* kp = proj + (tb2 + (long)(q02 - 128 + 32 * j02 + l31) * dil2) * INW + O1 + 768 + H2 * 64;
        for (int s = 0; s < 4; ++s) ak_n[s] = *(const bf16x8*)(kp + 16 * s + 8 * h);
        for (int c = 0; c < 4; ++c) vv_n[c] = *(const u32x4*)(kp + 768 + h * 32 + c * 8);
      }
      float mx = -1e30f;
      for (int i = 0; i < 16; ++i) {
        int dist = (q0 + l31) - (kb + crow(i, h));
        bool ok = (dist >= 0) && (dist <= 128);
        int di = min(max(dist, 0), 128);
        float s2 = sacc[i] * sc + bt[di];
        s2 = ok ? s2 : -1e30f;
        sacc[i] = s2; mx = fmaxf(mx, s2);
      }
      mx = fmaxf(mx, shflx(mx, 32, lane));
      float mnew = fmaxf(mrun, mx);
      float alpha = fexp2(mrun - mnew);
      float ps = 0.f;
      for (int i = 0; i < 16; ++i) { float pv = sacc[i] > -1e29f ? fexp2(sacc[i] - mnew) : 0.f; sacc[i] = pv; ps += pv; }
      lsum = lsum * alpha + ps; mrun = mnew;
      for (int e = 0; e < 2; ++e) for (int i = 0; i < 16; ++i) O[e][i] *= alpha;
      __builtin_amdgcn_wave_barrier();
      for (int s = 0; s < 2; ++s) {
        bf16x8 pf = packP(sacc, s);
        for (int e = 0; e < 2; ++e) {
          s16x4 lo = tr_read(vbuf + (16 * s + 4 * h + tq) * 144 + e * 64 + 32 * blk + 8 * tp);
          s16x4 hi = tr_read(vbuf + (16 * s + 8 + 4 * h + tq) * 144 + e * 64 + 32 * blk + 8 * tp);
          bf16x8 av = __builtin_shufflevector(lo, hi, 0, 1, 2, 3, 4, 5, 6, 7);
          O[e] = MFMA32(av, pf, O[e]);
        }
      }
      __builtin_amdgcn_wave_barrier();
      sacc = snx;
    }
    float ltot = lsum + shflx(lsum, 32, lane);
    float inv = 1.f / ltot;
    for (int e = 0; e < 2; ++e) for (int gq = 0; gq < 4; ++gq) {
      f32x4 o4 = {O[e][4 * gq] * inv, O[e][4 * gq + 1] * inv, O[e][4 * gq + 2] * inv, O[e][4 * gq + 3] * inv};
      store4bf(qp + 32 * e + 8 * gq + 4 * h, o4);
    }
    if (h == 0) lse[(tbase + (long)(q0 + l31) * dil) * 12 + H] = (mrun + flog2(ltot)) * 0.6931471805599453f;
  }
}

DI void mix_dil_merge(WVP u16* __restrict__ proj, const float* __restrict__ lse) {
  const int BID = get_bid(), GRD = get_grid();
  const int tid = get_tid(WV);
  for (long idx = (long)BID * NTHR + tid; idx < (long)TOK * 32; idx += (long)GRD * NTHR) {
    int c8 = (int)(idx & 7), j = (int)(idx >> 3) & 3; long tok = idx >> 5;
    float l0 = lse[tok * 12 + j], l1 = lse[tok * 12 + 4 + j], l2 = lse[tok * 12 + 8 + j];
    float m = fmaxf(l0, fmaxf(l1, l2));
    float e0 = __expf(l0 - m), e1 = __expf(l1 - m), e2 = __expf(l2 - m), inv = 1.f / (e0 + e1 + e2);
    e0 *= inv; e1 *= inv; e2 *= inv;
    u16* base = proj + tok * INW + O1 + j * 64 + c8 * 8;
    uint4 a = *(const uint4*)base, b = *(const uint4*)(base + 256), c = *(const uint4*)(base + 512), o;
    o.x = pack2(e0 * bflo(a.x) + e1 * bflo(b.x) + e2 * bflo(c.x), e0 * bfhi(a.x) + e1 * bfhi(b.x) + e2 * bfhi(c.x));
    o.y = pack2(e0 * bflo(a.y) + e1 * bflo(b.y) + e2 * bflo(c.y), e0 * bfhi(a.y) + e1 * bfhi(b.y) + e2 * bfhi(c.y));
    o.z = pack2(e0 * bflo(a.z) + e1 * bflo(b.z) + e2 * bflo(c.z), e0 * bfhi(a.z) + e1 * bfhi(b.z) + e2 * bfhi(c.z));
    o.w = pack2(e0 * bflo(a.w) + e1 * bflo(b.w) + e2 * bflo(c.w), e0 * bfhi(a.w) + e1 * bfhi(b.w) + e2 * bfhi(c.w));
    *(uint4*)base = o;
  }
}

DI void mix_sb(WVP u16* __restrict__ proj, char* smem) {
  const int BID = get_bid(), GRD = get_grid();
  const int tid = get_tid(WV), wave = wave_of(tid), lane = tid & 63, h = lane >> 5, l31 = lane & 31;
  constexpr int RS = 272, TB = 32 * RS;
  char* kbuf = smem; char* vbuf = smem + 2 * TB; int* flags = (int*)(smem + 4 * TB);
  const int i16 = lane & 15, tq = i16 >> 2, tp = i16 & 3, blk = (lane >> 4) & 1;
  const float sc = 1.44269504089f * 0.08838834764831845f;
  const float RTH = -60.f;
  const int lrow = tid >> 4, lch = tid & 15;
  for (int it = BID; it < BATCH * 4 * 16; it += GRD) {
    int qb = 15 - (it & 15), hh = (it >> 4) & 3, b = it >> 6;
    int Q0 = qb * 256;
    u16* base = proj + (long)b * SEQ * INW + O2 + hh * 128;
    u16* qp = base + (long)(Q0 + 32 * wave + l31) * INW;
    bf16x8 bq[8];
    for (int s = 0; s < 8; ++s) bq[s] = *(const bf16x8*)(qp + 16 * s + 8 * h);
    f32x16 O[4]; for (int e = 0; e < 4; ++e) for (int i = 0; i < 16; ++i) O[e][i] = 0.f;
    float R = 0.f;
    const int kt_hi = Q0 / 32 + 7, kt_diag = Q0 / 32 + wave;
    __syncthreads();
    if (tid < 16) flags[tid] = 0;
    {
      const u16* kp = base + 512 + (long)(kt_hi * 32 + lrow) * INW + lch * 8;
      uint4 kv = *(const uint4*)kp, vv = *(const uint4*)(kp + 512);
      *(uint4*)(kbuf + lrow * RS + lch * 16) = kv; *(uint4*)(vbuf + lrow * RS + lch * 16) = vv;
    }
    __syncthreads();
    int cur = 0, iter = 0;
    for (int kt = kt_hi; kt >= 0; --kt, ++iter) {
      uint4 kv, vv;
      const bool more = kt > 0;
      if (more) { const u16* kp = base + 512 + (long)((kt - 1) * 32 + lrow) * INW + lch * 8; kv = *(const uint4*)kp; vv = *(const uint4*)(kp + 512); }
      bool wdone = false;
      if (kt <= kt_diag) {
        const char* kb_ = kbuf + cur * TB; const char* vb_ = vbuf + cur * TB;
        f32x16 sacc; for (int i = 0; i < 16; ++i) sacc[i] = 0.f;
        for (int s = 0; s < 8; ++s) { bf16x8 ak = *(const bf16x8*)(kb_ + l31 * RS + 32 * s + 16 * h); sacc = MFMA32(ak, bq[s], sacc); }
        const bool diag = (kt == kt_diag);
        float ls[16];
        for (int i = 0; i < 16; ++i) {
          float z2 = sacc[i] * sc;
          float sp = fmaxf(z2, 0.f) + flog2(1.f + fexp2(-fabsf(z2)));
          bool ok = !diag || (crow(i, h) < l31);
          ls[i] = ok ? -sp : 0.f;
          sacc[i] = ok ? z2 : -1e30f;
        }
        float G[4], Gp[4], tot[4];
        for (int g = 0; g < 4; ++g) G[g] = (ls[4 * g] + ls[4 * g + 1]) + (ls[4 * g + 2] + ls[4 * g + 3]);
        for (int g = 0; g < 4; ++g) { Gp[g] = shflx(G[g], 32, lane); tot[g] = G[g] + Gp[g]; }
        float after = 0.f;
        for (int g = 3; g >= 0; --g) {
          float tail = R + after + (h == 0 ? Gp[g] : 0.f);
          float c3 = tail + ls[4 * g + 3], c2 = c3 + ls[4 * g + 2], c1 = c2 + ls[4 * g + 1], c0 = c1 + ls[4 * g];
          sacc[4 * g + 3] = fexp2(sacc[4 * g + 3] + c3); sacc[4 * g + 2] = fexp2(sacc[4 * g + 2] + c2);
          sacc[4 * g + 1] = fexp2(sacc[4 * g + 1] + c1); sacc[4 * g] = fexp2(sacc[4 * g] + c0);
          after += tot[g];
        }
        R += after;
        for (int s = 0; s < 2; ++s) {
          bf16x8 pf = packP(sacc, s);
          for (int e = 0; e < 4; ++e) {
            s16x4 lo = tr_read(vb_ + (16 * s + 4 * h + tq) * RS + e * 64 + 32 * blk + 8 * tp);
            s16x4 hi = tr_read(vb_ + (16 * s + 8 + 4 * h + tq) * RS + e * 64 + 32 * blk + 8 * tp);
            bf16x8 av = __builtin_shufflevector(lo, hi, 0, 1, 2, 3, 4, 5, 6, 7);
            O[e] = MFMA32(av, pf, O[e]);
          }
        }
        wdone = __all(R < RTH);
      }
      if (lane == 0) flags[(iter & 1) * 8 + wave] = wdone ? 1 : 0;
      if (more) { *(uint4*)(kbuf + (cur ^ 1) * TB + lrow * RS + lch * 16) = kv; *(uint4*)(vbuf + (cur ^ 1) * TB + lrow * RS + lch * 16) = vv; }
      __syncthreads();
      cur ^= 1;
      int nd = 0;
      for (int w2 = 0; w2 < 8; ++w2) nd += flags[(iter & 1) * 8 + w2];
      if (nd == 8) break;
    }
    for (int e = 0; e < 4; ++e) for (int gq = 0; gq < 4; ++gq) {
      f32x4 o4 = {O[e][4 * gq], O[e][4 * gq + 1], O[e][4 * gq + 2], O[e][4 * gq + 3]};
      store4bf(qp + 32 * e + 8 * gq + 4 * h, o4);
    }
  }
}

DI void mix_s5(WVP CP pp, int l, u16* __restrict__ proj, char* smem) {
  const int BID = get_bid(), GRD = get_grid();
  const int tid = get_tid(WV), wave = wave_of(tid), lane = tid & 63, h = lane >> 5, l31 = lane & 31;
  constexpr int RSF = 132;
  float* buf = (float*)smem + wave * 32 * RSF;
  float* hend = (float*)(smem + 8 * 32 * RSF * 4);
  for (int it = BID; it < BATCH * 32; it += GRD) {
    const int g = it & 31, b = it >> 5;
    const float* a_re = pp->in[6] + ((size_t)l * 32 + g) * 64;
    const float* a_im = pp->in[7] + ((size_t)l * 32 + g) * 64;
    const float dt = __expf(pp->in[8][l * 32 + g]);
    const float* b_re = pp->in[9] + ((size_t)l * 32 + g) * 64 * 16;
    const float* b_im = pp->in[10] + ((size_t)l * 32 + g) * 64 * 16;
    const float* c_re = pp->in[11] + ((size_t)l * 32 + g) * 16 * 64;
    const float* c_im = pp->in[12] + ((size_t)l * 32 + g) * 16 * 64;
    const float* dsk = pp->in[13] + (size_t)l * 512 + g * 16;
    float lr, li;
    { float ar = a_re[lane], ai = a_im[lane]; float mg = expf(ar * dt); float sn, cs; sincosf(ai * dt, &sn, &cs); lr = mg * cs; li = mg * sn; }
    bf16x8 bfrag[4];
    float lam_r[2], lam_i[2];
    for (int half = 0; half < 2; ++half) {
      int ps = 32 * half + l31;
      float ar = a_re[ps], ai = a_im[ps]; float mg = expf(ar * dt); float sn, cs; sincosf(ai * dt, &sn, &cs);
      lam_r[half] = mg * cs; lam_i[half] = mg * sn;
      float xr = mg * cs - 1.f, xi = mg * sn, den = 1.f / (ar * ar + ai * ai);
      float cr = (xr * ar + xi * ai) * den, ci = (xi * ar - xr * ai) * den;
      float vr[8], vi[8];
      for (int j = 0; j < 8; ++j) { float br = b_re[ps * 16 + 8 * h + j], bi = b_im[ps * 16 + 8 * h + j]; vr[j] = cr * br - ci * bi; vi[j] = cr * bi + ci * br; }
      uint4 a = {pack2(vr[0], vr[1]), pack2(vr[2], vr[3]), pack2(vr[4], vr[5]), pack2(vr[6], vr[7])};
      uint4 c = {pack2(vi[0], vi[1]), pack2(vi[2], vi[3]), pack2(vi[4], vi[5]), pack2(vi[6], vi[7])};
      bfrag[half] = __builtin_bit_cast(bf16x8, a); bfrag[2 + half] = __builtin_bit_cast(bf16x8, c);
    }
    u16* ub = proj + ((long)b * SEQ + wave * 512) * INW + O3 + g * 16;
    float hr = 0.f, hi = 0.f;
    __syncthreads();
    if (wave < 7) {
#pragma nounroll
      for (int half = 0; half < 2; ++half) {
        float Hr = 0.f, Hi = 0.f;
        float wre[16], wim[16];
        const float ar = half ? lam_r[1] : lam_r[0], ai = half ? lam_i[1] : lam_i[0];
        const float l2r = ar * ar - ai * ai, l2i = 2.f * ar * ai;
        const float l4r = l2r * l2r - l2i * l2i, l4i = 2.f * l2r * l2i;
        const float l5r = l4r * ar - l4i * ai, l5i = l4r * ai + l4i * ar;
        const float l8r = l4r * l4r - l4i * l4i, l8i = 2.f * l4r * l4i;
        const float l16r = l8r * l8r - l8i * l8i, l16i = 2.f * l8r * l8i;
        const float l32r = l16r * l16r - l16i * l16i, l32i = 2.f * l16r * l16i;
        float cr = h ? 1.f : l4r, ci = h ? 0.f : l4i;
#pragma unroll
        for (int i = 15; i >= 0; --i) {
          wre[i] = cr; wim[i] = ci;
          const float mr = (i & 3) ? ar : l5r, mi = (i & 3) ? ai : l5i;
          const float nr = cr * mr - ci * mi, ni = cr * mi + ci * mr; cr = nr; ci = ni;
        }
        const bf16x8 bfr = half ? bfrag[1] : bfrag[0], bfi = half ? bfrag[3] : bfrag[2];
        bf16x8 au_n = *(const bf16x8*)(ub + (long)l31 * INW + 8 * h);
        f32x16 z; for (int i = 0; i < 16; ++i) z[i] = 0.f;
#pragma nounroll
        for (int ch = 0; ch < 16; ++ch) {
          const bf16x8 au = au_n;
          if (ch + 1 < 16) au_n = *(const bf16x8*)(ub + (long)((ch + 1) * 32 + l31) * INW + 8 * h);
          const f32x16 bre = MFMA32(au, bfr, z), bim = MFMA32(au, bfi, z);
          float sr = 0.f, si = 0.f;
#pragma unroll
          for (int i = 0; i < 16; ++i) { sr += wre[i] * bre[i] - wim[i] * bim[i]; si += wre[i] * bim[i] + wim[i] * bre[i]; }
          sr += shflx(sr, 32, lane); si += shflx(si, 32, lane);
          const float nr = l32r * Hr - l32i * Hi + sr, ni = l32r * Hi + l32i * Hr + si;
          Hr = nr; Hi = ni;
        }
        if (h == 0) { hend[wave * 128 + 32 * half + l31] = Hr; hend[wave * 128 + 64 + 32 * half + l31] = Hi; }
      }
    }
    __syncthreads();
    asm volatile("" : "+s"(c_re), "+s"(c_im), "+s"(dsk));
    bf16x8 cfrag[4];
    { int c = lane & 15, kq = lane >> 4;
      for (int s = 0; s < 4; ++s) {
        float v[8];
        for (int j = 0; j < 8; ++j) { int k = 32 * s + 8 * kq + j; v[j] = k < 64 ? c_re[c * 64 + k] : -c_im[c * 64 + k - 64]; }
        uint4 a = {pack2(v[0], v[1]), pack2(v[2], v[3]), pack2(v[4], v[5]), pack2(v[6], v[7])};
        cfrag[s] = __builtin_bit_cast(bf16x8, a);
      } }
    {
      {
        float pr_ = lr, pi_ = li;
        for (int k = 0; k < 9; ++k) { float nr = pr_ * pr_ - pi_ * pi_, ni = 2.f * pr_ * pi_; pr_ = nr; pi_ = ni; }
        hr = 0.f; hi = 0.f;
        for (int v = 0; v < wave; ++v) { float er = hend[v * 128 + lane], ei = hend[v * 128 + 64 + lane]; float nr = pr_ * hr - pi_ * hi + er, ni = pr_ * hi + pi_ * hr + ei; hr = nr; hi = ni; }
      }
      LAS char* img = (LAS char*)buf;
      const int cch = lane & 15, kqq = lane >> 4, tq = cch >> 2, tp = cch & 3;
      bf16x8 au_n = *(const bf16x8*)(ub + (long)l31 * INW + 8 * h);
      uint2 us_n[2];
      for (int q = 0; q < 2; ++q) us_n[q] = *(const uint2*)(ub + (long)(16 * q + cch) * INW + 4 * kqq);
      const f32x4 d4 = *(const f32x4*)(dsk + 4 * kqq);
#pragma nounroll
      for (int ch = 0; ch < 16; ++ch) {
        u16* up = ub + (long)(ch * 32) * INW;
        const bf16x8 au = au_n;
        uint2 us[2];
        for (int q = 0; q < 2; ++q) us[q] = us_n[q];
        if (ch + 1 < 16) {
          const u16* un = up + (long)32 * INW;
          au_n = *(const bf16x8*)(un + (long)l31 * INW + 8 * h);
          for (int q = 0; q < 2; ++q) us_n[q] = *(const uint2*)(un + (long)(16 * q + cch) * INW + 4 * kqq);
        }
        f32x16 z; for (int i = 0; i < 16; ++i) z[i] = 0.f;
#pragma unroll
        for (int nt = 0; nt < 4; ++nt) {
          const f32x16 bu = MFMA32(au, bfrag[nt], z);
          const int row = (nt >> 1) * 64 + (nt & 1) * 32 + l31;
#pragma unroll
          for (int g4 = 0; g4 < 4; ++g4)
            *(LAS f32x4*)(img + row * 128 + (((2 * g4 + h) ^ (row & 7)) << 4)) = f32x4{bu[4 * g4], bu[4 * g4 + 1], bu[4 * g4 + 2], bu[4 * g4 + 3]};
          __builtin_amdgcn_sched_barrier(0);
        }
        __builtin_amdgcn_wave_barrier();
        {
          float sre[32], sim[32];
#pragma unroll
          for (int c8 = 0; c8 < 8; ++c8) {
            const f32x4 a = *(const LAS f32x4*)(img + lane * 128 + ((c8 ^ (lane & 7)) << 4)), b2 = *(const LAS f32x4*)(img + (64 + lane) * 128 + ((c8 ^ (lane & 7)) << 4));
            for (int q = 0; q < 4; ++q) { sre[4 * c8 + q] = a[q]; sim[4 * c8 + q] = b2[q]; }
          }
#pragma unroll
          for (int t = 0; t < 32; ++t) {
            float nr = lr * hr - li * hi + sre[t], ni = lr * hi + li * hr + sim[t]; hr = nr; hi = ni; sre[t] = hr; sim[t] = hi;
          }
          __builtin_amdgcn_wave_barrier();
#pragma unroll
          for (int c4 = 0; c4 < 4; ++c4) {
            u32x4 wr_ = {pack2(sre[8 * c4], sre[8 * c4 + 1]), pack2(sre[8 * c4 + 2], sre[8 * c4 + 3]), pack2(sre[8 * c4 + 4], sre[8 * c4 + 5]), pack2(sre[8 * c4 + 6], sre[8 * c4 + 7])};
            u32x4 wi_ = {pack2(sim[8 * c4], sim[8 * c4 + 1]), pack2(sim[8 * c4 + 2], sim[8 * c4 + 3]), pack2(sim[8 * c4 + 4], sim[8 * c4 + 5]), pack2(sim[8 * c4 + 6], sim[8 * c4 + 7])};
            const int pc4 = (c4 ^ ((lane >> 2) & 3)) << 4;
            *(LAS u32x4*)(img + lane * 64 + pc4) = wr_; *(LAS u32x4*)(img + (64 + lane) * 64 + pc4) = wi_;
          }
        }
        __builtin_amdgcn_wave_barrier();
#pragma unroll
        for (int mt = 0; mt < 2; ++mt) {
          f32x4 y = {0.f, 0.f, 0.f, 0.f};
#pragma unroll
          for (int s2 = 0; s2 < 4; ++s2) {
            const int clo = ((2 * mt + (tp >> 1)) ^ ((2 * kqq) & 3)) * 16 + (tp & 1) * 8, chi = ((2 * mt + (tp >> 1)) ^ ((2 * kqq + 1) & 3)) * 16 + (tp & 1) * 8;
            const s16x4 lo = __builtin_amdgcn_ds_read_tr16_b64_v4i16((LAS s16x4*)(img + (32 * s2 + 8 * kqq + tq) * 64 + clo));
            const s16x4 hi4 = __builtin_amdgcn_ds_read_tr16_b64_v4i16((LAS s16x4*)(img + (32 * s2 + 8 * kqq + 4 + tq) * 64 + chi));
            const bf16x8 hb = __builtin_shufflevector(lo, hi4, 0, 1, 2, 3, 4, 5, 6, 7);
            y = MFMA16(cfrag[s2], hb, y);
          }
          f32x4 o4;
          o4[0] = gelu_tanh(y[0] + d4[0] * bflo(us[mt].x)); o4[1] = gelu_tanh(y[1] + d4[1] * bfhi(us[mt].x));
          o4[2] = gelu_tanh(y[2] + d4[2] * bflo(us[mt].y)); o4[3] = gelu_tanh(y[3] + d4[3] * bfhi(us[mt].y));
          store4bf(up + (long)(16 * mt + cch) * INW + 4 * kqq, o4);
        }
        __builtin_amdgcn_wave_barrier();
      }
    }
    __syncthreads();
  }
}


#define XB_TMO      128
#define XB_XCNT(j)  (256  + 64 * (j))
#define XB_XSUB(j)  (1280 + 64 * (j))
#define XB_XGEN(j)  (2304 + 64 * (j))
#define XB_TOP      3328
#define XB_TOPGEN   3392
#define XCD_BAR_WORDS 3456
#define XB_SPIN_CAP (1u << 22)
DI unsigned xb_ld(unsigned* p)              { return __hip_atomic_load(p, __ATOMIC_RELAXED, __HIP_MEMORY_SCOPE_AGENT); }
DI unsigned xb_add(unsigned* p, unsigned v) { return __hip_atomic_fetch_add(p, v, __ATOMIC_RELAXED, __HIP_MEMORY_SCOPE_AGENT); }
DI unsigned xb_xcc_id() { return (unsigned)__builtin_amdgcn_s_getreg((3 << 11) | 20) & 0xFu; }
#define XB_SPIN(cond, bar) do { unsigned _sp = 0; while (cond) { __builtin_amdgcn_s_sleep(1); \
    if ((++_sp & 255u) == 0u) { if (xb_ld(&(bar)[XB_TMO])) break; if (_sp > XB_SPIN_CAP) { atomicAdd(&(bar)[XB_TMO], 1u); break; } } } } while (0)
struct XcdBarrier { unsigned* bar; unsigned x; volatile LAS unsigned* st; };
DI XcdBarrier xcd_barrier_post(unsigned* bar, volatile LAS unsigned* st) {
  XcdBarrier b; b.bar = bar; b.x = xb_xcc_id(); b.st = st;
  if (threadIdx.x == 0) (void)xb_add(&bar[XB_XCNT(b.x)], 1u);
  return b;
}
DI void xcd_barrier_complete(unsigned* bar, unsigned x, unsigned& nloc, unsigned& nx) {
  const unsigned G = gridDim.x * gridDim.y * gridDim.z;
  unsigned sum, cnt, mine, sp = 0u;
  for (;;) {
    sum = 0u; cnt = 0u; mine = 0u;
#pragma unroll
    for (unsigned j = 0; j < 16; ++j) { const unsigned c = xb_ld(&bar[XB_XCNT(j)]); sum += c; cnt += (c > 0u) ? 1u : 0u; mine = (j == x) ? c : mine; }
    if (sum == G) break;
    __builtin_amdgcn_s_sleep(1);
    if ((++sp & 255u) == 0u) { if (xb_ld(&bar[XB_TMO])) break; if (sp > XB_SPIN_CAP) { atomicAdd(&bar[XB_TMO], 1u); break; } }
  }
  nloc = mine > 0u ? mine : 1u; nx = cnt > 0u ? cnt : 1u;
}
DI void xcd_barrier(const XcdBarrier& b) {
  asm volatile("s_waitcnt vmcnt(0)" ::: "memory");
  __syncthreads();
  if (threadIdx.x == 0) {
    unsigned* bar = b.bar;
    __builtin_amdgcn_s_waitcnt(0);
    unsigned nloc = b.st[0], nx = b.st[1];
    if (nloc == 0u) { xcd_barrier_complete(bar, b.x, nloc, nx); b.st[0] = nloc; b.st[1] = nx; }
    const unsigned old = xb_add(&bar[XB_XSUB(b.x)], 1u);
    const unsigned gen = old / nloc;
    if (old + 1u == (gen + 1u) * nloc) {
      __builtin_amdgcn_fence(__ATOMIC_RELEASE, "agent");
      asm volatile("s_waitcnt vmcnt(0)" ::: "memory");
      const unsigned og = xb_add(&bar[XB_TOP], 1u);
      const unsigned tg = og / nx;
      if (og + 1u == (tg + 1u) * nx) xb_add(&bar[XB_TOPGEN], 1u);
      else XB_SPIN(xb_ld(&bar[XB_TOPGEN]) == tg, bar);
      __builtin_amdgcn_fence(__ATOMIC_ACQUIRE, "agent");
      xb_add(&bar[XB_XGEN(b.x)], 1u);
      asm volatile("s_waitcnt vmcnt(0)" ::: "memory");
    } else {
      XB_SPIN(xb_ld(&bar[XB_XGEN(b.x)]) == gen, bar);
      __builtin_amdgcn_fence(__ATOMIC_ACQUIRE, "agent");
      asm volatile("s_waitcnt vmcnt(0)" ::: "memory");
    }
  }
  __syncthreads();
}

__global__ void __launch_bounds__(NTHR) mega(Params p) {
  extern __shared__ __attribute__((aligned(16))) char smem[];

  const int ph_lo = p.ph_lo, ph_hi = p.ph_hi;
  const int WV = __builtin_amdgcn_readfirstlane(threadIdx.x >> 6);
  volatile LAS unsigned* xst = (volatile LAS unsigned*)(smem + LDS_BYTES - 16);
  if (threadIdx.x == 0) { xst[0] = 0u; xst[1] = 0u; }
  __syncthreads();
  (void)xcd_barrier_post((unsigned*)(p.ws + WS_BAR), xst);
  for (int ph = ph_lo; ph < ph_hi; ++ph) {
    if (ph == ph_lo + 1) cg::this_grid().sync();
    else if (ph > ph_lo) {
      CP pb_ = (CP)__builtin_amdgcn_kernarg_segment_ptr(); asm volatile("" : "+s"(pb_));
      XcdBarrier xbar; xbar.bar = (unsigned*)(pb_->ws + WS_BAR); xbar.x = xb_xcc_id(); xbar.st = (volatile LAS unsigned*)(smem + LDS_BYTES - 16);
      xcd_barrier(xbar);
    }
    const int BID = get_bid(), G = get_grid();
    CP pp = (CP)__builtin_amdgcn_kernarg_segment_ptr(); asm volatile("" : "+s"(pp));
    char* ws = pp->ws;
    u16* proj = (u16*)(ws + WS_PROJ);
    u16* xn = (u16*)(ws + WS_XN);
    u16* pb = (u16*)(ws + WS_PB);
    u16* mg = (u16*)(ws + WS_MG);
    float* lse = (float*)(ws + WS_LSE);
    u16* hbuf = proj;
    const u16* WIN = (const u16*)(ws + WS_WIN); const u16* WG = (const u16*)(ws + WS_WG); const u16* WB = (const u16*)(ws + WS_WB);
    const u16* WO = (const u16*)(ws + WS_WO); const u16* WUP = (const u16*)(ws + WS_WUP); const u16* WDN = (const u16*)(ws + WS_WDN);
    const u16* WGLU = (const u16*)(ws + WS_WGLU);
    float* xres = pp->out;
    const int l = ph / PH_PER_LAYER, k = ph % PH_PER_LAYER;
    if (ph == N_PHASES - 1) { phase_final_norm(WV, xres, pp->in[21]); continue; }
    const float* xin = (l == 0) ? pp->in[0] : xres;
    switch (k) {
      case 0: {
        phase_rmsnorm(WV, xin, pp->in[1] + (size_t)l * DM, xn);
        phase_wprep(WV, pp, l, smem);
      } break;
      case 1: {
        const int nR = INW / 256, nC = TOK / 256, nwg = nR * nC;
        for (int id = BID; id < nwg; id += G) {
          int pr, pc; tile_map(id, nwg, nR, nC, pr, pc);
          EpiStore2 E{proj, INW, pr * 256, pr * 256 + 128};
          gemm_tile_staged(WV, smem, WIN, DM, pr * 256, pr * 256 + 128, xn, DM, pc * 256, DM, E);
        }
      } break;
      case 2: {
        mix_s5(WV, pp, l, proj, smem);
        mix_sb(WV, proj, smem);
        mix_dil(WV, proj, lse, pp->in[5], smem);
        mix_pool(WV, proj, pb);
      } break;
      case 3: {
        const int nR = 4, nC = TOK / 256, nwg = nR * nC;
        for (int id = BID; id < nwg; id += G) {
          int pr, pc; tile_map(id, nwg, nR, nC, pr, pc);
          EpiGated<1> E{proj, INW, O2 + 512 + pr * 128};
          gemm_tile_staged(WV, smem, WGLU, 512, pr * 128, 512 + pr * 128, proj + O3, INW, pc * 256, 512, E);
        }
        mix_dil_merge(WV, proj, lse);
      } break;
      case 4: {
        const int nR = 4, nC = TOK / 256, nwg = nR * nC;
        for (int id = BID; id < nwg; id += G) {
          int pr, pc; tile_map(id, nwg, nR, nC, pr, pc);
#pragma nounroll
          for (int b = 0; b < 4; ++b) {
            const int q = pr * 3 + b;
            u16* sd = (b == 3) ? mg + pr * 256 : proj + (q < 8 ? 768 + 256 * q : (q < 10 ? 256 * (q - 8) : 3840 + 256 * (q - 10)));
            EpiSig E1{sd, b == 3 ? DM : INW, pc * 256};
            gemm_tile(WV, smem, WG + (size_t)b * DM * DM, DM, pr * 256, pr * 256 + 128, xn, DM, pc * 256, DM, E1);
          }
          AccT acc = {};
#pragma nounroll
          for (int b = 0; b < 4; ++b) {
            const int Kb = (b == 1) ? 256 : 512, ldy = (b == 0) ? 512 : INW;
            const u16* yb = (b == 0) ? pb : proj + (b == 1 ? O1 : (b == 2 ? O2 : O2 + 512));
            const u16* wb = WB + DM * (b == 0 ? 0 : (b == 1 ? 512 : (b == 2 ? 768 : 1280)));
            gemm_core(WV, smem, wb, Kb, pr * 256, pr * 256 + 128, yb, ldy, pc * 256, Kb, acc);
            if (b < 3) {
              const int q = pr * 3 + b, q1 = q + 1;
              u16* sc = proj + (q < 8 ? 768 + 256 * q : (q < 10 ? 256 * (q - 8) : 3840 + 256 * (q - 10)));
              u16* sn = (b == 2) ? mg + pr * 256 : proj + (q1 < 8 ? 768 + 256 * q1 : (q1 < 10 ? 256 * (q1 - 8) : 3840 + 256 * (q1 - 10)));
              EpiRescale E2{sc, INW, sn, b == 2 ? DM : INW, pc * 256};
              apply_epi(WV, acc, pc * 256, E2);
            }
          }
          EpiFinalGate E3{mg, pr * 256, pc * 256};
          apply_epi_staged(WV, smem, acc, pc * 256, E3);
        }
      } break;
      case 5: {
        const int nR = 4, nC = TOK / 256, nwg = nR * nC;
        for (int id = BID; id < nwg; id += G) {
          int pr, pc; tile_map(id, nwg, nR, nC, pr, pc);
          EpiResid E{xin, xres, pr * 256, pr * 256 + 128};
          gemm_tile(WV, smem, WO, DM, pr * 256, pr * 256 + 128, mg, DM, pc * 256, DM, E);
        }
      } break;
      case 6: phase_rmsnorm(WV, xres, pp->in[18] + (size_t)l * DM, xn); break;
      case 7: {
        const int nR = FFN / 128, nC = TOK / 256, nwg = nR * nC;
        for (int id = BID; id < nwg; id += G) {
          int pr, pc; tile_map(id, nwg, nR, nC, pr, pc);
          EpiGated<0> E{hbuf, FFN, pr * 128};
          gemm_tile_staged(WV, smem, WUP, DM, pr * 128, FFN + pr * 128, xn, DM, pc * 256, DM, E);
        }
      } break;
      case 8: {
        const int nR = 4, nC = TOK / 256, nwg = nR * nC;
        for (int id = BID; id < nwg; id += G) {
          int pr, pc; tile_map(id, nwg, nR, nC, pr, pc);
          EpiResid E{xres, xres, pr * 256, pr * 256 + 128};
          gemm_tile(WV, smem, WDN, FFN, pr * 256, pr * 256 + 128, hbuf, FFN, pc * 256, FFN, E);
        }
      } break;
    }
  }
}

extern "C" void kernel_launch(void* const* d_in, const int* in_sizes, int n_in, void* d_out, int out_size,
                              void* d_ws, size_t ws_size, hipStream_t stream) {
  static int grid = 0;
  if (grid == 0) {
    if (n_in != 22 || ws_size < WS_END) { fprintf(stderr, "kernel_launch: unexpected n_in %d / ws_size %zu (need %zu)\n", n_in, ws_size, (size_t)WS_END); grid = -1; return; }
    int dev = 0, cus = 0, per_cu = 0;
    hipGetDevice(&dev);
    hipDeviceGetAttribute(&cus, hipDeviceAttributeMultiprocessorCount, dev);
    if (hipFuncSetAttribute((const void*)mega, hipFuncAttributeMaxDynamicSharedMemorySize, LDS_BYTES) != hipSuccess) { fprintf(stderr, "hipFuncSetAttribute failed\n"); grid = -1; return; }
    if (hipOccupancyMaxActiveBlocksPerMultiprocessor(&per_cu, (const void*)mega, NTHR, LDS_BYTES) != hipSuccess || per_cu < 1) { fprintf(stderr, "occupancy query failed (%d)\n", per_cu); per_cu = 1; (void)hipGetLastError(); }
    grid = cus * per_cu;
  }
  if (grid < 0) return;
  if (hipMemsetAsync((char*)d_ws + WS_BAR, 0, 16384, stream) != hipSuccess) { fprintf(stderr, "memset of barrier words failed\n"); return; }
  Params p{};
  for (int i = 0; i < 22; ++i) p.in[i] = (const float*)d_in[i];
  p.out = (float*)d_out; p.ws = (char*)d_ws;
#if ONE_LAUNCH
  p.ph_lo = 0; p.ph_hi = N_PHASES;
  void* args[] = {&p};
  hipError_t e = hipLaunchCooperativeKernel((const void*)mega, dim3(grid), dim3(NTHR), args, LDS_BYTES, stream);
  if (e != hipSuccess) fprintf(stderr, "cooperative launch failed: %s (grid %d)\n", hipGetErrorString(e), grid);
#else
  for (int ph = 0; ph < N_PHASES; ++ph) {
    p.ph_lo = ph; p.ph_hi = ph + 1;
    hipLaunchKernelGGL(mega, dim3(grid), dim3(NTHR), LDS_BYTES, stream, p);
  }
#endif
}
```

```cpp
#include <hip/hip_runtime.h>
#include <hip/hip_bf16.h>
#include <hip/hip_cooperative_groups.h>
#include <cstdio>
namespace cg = cooperative_groups;

#ifndef ONE_LAUNCH
#define ONE_LAUNCH 1
#endif

typedef unsigned short u16;
using bf16x8 = __attribute__((ext_vector_type(8))) short;
using s16x4  = __attribute__((ext_vector_type(4))) short;
using f32x4  = __attribute__((ext_vector_type(4))) float;
using f32x16 = __attribute__((ext_vector_type(16))) float;
using u32x4  = __attribute__((ext_vector_type(4))) unsigned;
typedef __bf16 bf2_t __attribute__((ext_vector_type(2)));
typedef float f2_t __attribute__((ext_vector_type(2)));
#define DI __device__ __forceinline__
#define LAS __attribute__((address_space(3)))

constexpr int DM = 1024, BATCH = 8, SEQ = 4096, TOK = BATCH * SEQ, DEPTH = 4;
constexpr int INW = 4864, O1 = 512, O2 = 2816, O3 = 4352;
constexpr int FFN = 2816;
constexpr int NTHR = 512;
constexpr int LDS_BYTES = 147456;
constexpr int PH_PER_LAYER = 9, N_PHASES = DEPTH * PH_PER_LAYER + 1;

constexpr size_t WS_PROJ = 0;
constexpr size_t WS_XN   = WS_PROJ + (size_t)TOK * INW * 2;
constexpr size_t WS_PB   = WS_XN + (size_t)TOK * DM * 2;
constexpr size_t WS_MG   = WS_PB + (size_t)TOK * 512 * 2;
constexpr size_t WS_LSE  = WS_MG + (size_t)TOK * DM * 2;
constexpr size_t WS_WIN  = WS_LSE + (size_t)TOK * 12 * 4;
constexpr size_t WS_WG   = WS_WIN + (size_t)INW * DM * 2;
constexpr size_t WS_WB   = WS_WG + (size_t)4 * DM * DM * 2;
constexpr size_t WS_WO   = WS_WB + (size_t)DM * 1792 * 2;
constexpr size_t WS_WUP  = WS_WO + (size_t)DM * DM * 2;
constexpr size_t WS_WDN  = WS_WUP + (size_t)2 * FFN * DM * 2;
constexpr size_t WS_WGLU = WS_WDN + (size_t)DM * FFN * 2;
constexpr size_t WS_BAR  = WS_WGLU + (size_t)DM * 512 * 2;
constexpr size_t WS_SLAB = WS_BAR + 16384;
constexpr size_t WS_END  = WS_SLAB + (size_t)128 * 4 * 256 * 8;

struct Params {
  const float* in[22];
  float* out;
  char* ws;
  int ph_lo, ph_hi;
};
typedef const Params __attribute__((address_space(4)))* CP;

DI unsigned pack2(float a, float b) { f2_t v = {a, b}; bf2_t r = __builtin_convertvector(v, bf2_t); return __builtin_bit_cast(unsigned, r); }
DI u16 f2bf(float a) { return (u16)(pack2(a, 0.f) & 0xffffu); }
DI float bf2f(u16 v) { return __uint_as_float(((unsigned)v) << 16); }
DI float bflo(unsigned v) { return __uint_as_float(v << 16); }
DI float bfhi(unsigned v) { return __uint_as_float(v & 0xffff0000u); }
DI void store4bf(u16* p, f32x4 a) { uint2 v; v.x = pack2(a[0], a[1]); v.y = pack2(a[2], a[3]); *(uint2*)p = v; }
DI f32x4 load4bf(const u16* p) { uint2 v = *(const uint2*)p; f32x4 r = {bflo(v.x), bfhi(v.x), bflo(v.y), bfhi(v.y)}; return r; }
DI float fexp2(float x) { return __builtin_amdgcn_exp2f(x); }
DI float flog2(float x) { return __builtin_amdgcn_logf(x); }
DI float frcp(float x) { return __builtin_amdgcn_rcpf(x); }
DI float sigmoidf_(float x) { return frcp(1.f + fexp2(-1.44269504089f * x)); }
DI float siluf_(float x) { return x * sigmoidf_(x); }
DI float gelu_tanh(float x) {
  float u = 0.7978845608028654f * (x + 0.044715f * x * x * x);
  float e = fexp2(2.885390081777927f * u);
  float th = 1.f - 2.f * frcp(1.f + e);
  return 0.5f * x * (1.f + th);
}
DI int get_tid(int wv) { int l; asm volatile("v_mbcnt_lo_u32_b32 %0, -1, 0\n\tv_mbcnt_hi_u32_b32 %0, -1, %0" : "=v"(l)); return wv * 64 + l; }
DI int get_bid() { int b = blockIdx.x; asm volatile("" : "+s"(b)); return b; }
DI int get_grid() { int g = gridDim.x; asm volatile("" : "+s"(g)); return g; }
DI int wave_of(int tid) { return __builtin_amdgcn_readfirstlane(tid >> 6); }
#define WVP const int WV,
DI float shflx(float v, int mask, int lane) { return __int_as_float(__builtin_amdgcn_ds_bpermute((lane ^ mask) << 2, __float_as_int(v))); }
DI int crow(int i, int h) { return (i & 3) + 8 * (i >> 2) + 4 * h; }
#define MFMA32(a, b, c) __builtin_amdgcn_mfma_f32_32x32x16_bf16((a), (b), (c), 0, 0, 0)
#define MFMA16(a, b, c) __builtin_amdgcn_mfma_f32_16x16x32_bf16((a), (b), (c), 0, 0, 0)
DI s16x4 tr_read(const char* p) { return __builtin_amdgcn_ds_read_tr16_b64_v4i16((LAS s16x4*)p); }
DI bf16x8 packP(const f32x16& x, int s) {
  unsigned a = pack2(x[8 * s], x[8 * s + 1]), b = pack2(x[8 * s + 2], x[8 * s + 3]);
  unsigned c = pack2(x[8 * s + 4], x[8 * s + 5]), d = pack2(x[8 * s + 6], x[8 * s + 7]);
  uint4 v = {a, b, c, d};
  return __builtin_bit_cast(bf16x8, v);
}

constexpr int BK = 64, HALF = 128, HT = HALF * BK;
DI int lds_byte(int r, int c) {
  int st = (r >> 4) * 2 + (c >> 5), rr = r & 15, cc = c & 31, ob = rr * 64 + cc * 2;
  return st * 1024 + (ob ^ (((ob >> 9) & 1) << 5));
}
DI void stage_rc(int b, int& R, int& C) {
  int st = b / 1024, sb = b % 1024, swz = sb ^ (((sb >> 9) & 1) << 5);
  R = (st >> 1) * 16 + swz / 64; C = (st & 1) * 32 + (swz % 64) / 2;
}

typedef f32x4 AccT[2][2][4][2];
DI void gemm_core(WVP char* smem, const u16* __restrict__ A, int lda, int ar0, int ar1,
                  const u16* __restrict__ B, int ldb, int bc0, int K, AccT& acc) {
  u16* shm = (u16*)smem;
#define SA(b, h) (shm + ((b) * 2 + (h)) * HT)
#define SB(b, h) (shm + (4 + (b) * 2 + (h)) * HT)
#define STAGE_A(P, br, kt) do { const char* _g = (const char*)(A + (long)(br) * lda + (long)(kt) * BK); \
    __builtin_amdgcn_global_load_lds((const unsigned*)(_g + (size_t)offA0), (unsigned*)((char*)(P) + sb0), 16, 0, 0); \
    __builtin_amdgcn_global_load_lds((const unsigned*)(_g + (size_t)lda * 128 + (size_t)offA0), (unsigned*)((char*)(P) + sb1), 16, 0, 0); } while (0)
#define STAGE_B(P, br, kt) do { const char* _g = (const char*)(B + (long)(br) * ldb + (long)(kt) * BK); \
    __builtin_amdgcn_global_load_lds((const unsigned*)(_g + (size_t)offB0), (unsigned*)((char*)(P) + sb0), 16, 0, 0); \
    __builtin_amdgcn_global_load_lds((const unsigned*)(_g + (size_t)ldb * 128 + (size_t)offB0), (unsigned*)((char*)(P) + sb1), 16, 0, 0); } while (0)
#define LDA(dst, b, h) for (int m = 0; m < 4; ++m) for (int k = 0; k < 2; ++k) \
    dst[m][k] = *reinterpret_cast<const bf16x8*>((char*)SA(b, h) + lds_byte(wr * 64 + m * 16 + fr, k * 32 + fq * 8))
#define LDB(dst, b, h) for (int n = 0; n < 2; ++n) for (int k = 0; k < 2; ++k) \
    dst[n][k] = *reinterpret_cast<const bf16x8*>((char*)SB(b, h) + lds_byte(wc * 32 + n * 16 + fr, k * 32 + fq * 8))
#define MMA(ai, bj, At_, Bt_) do { __builtin_amdgcn_s_setprio(1); \
    for (int m = 0; m < 4; ++m) for (int n = 0; n < 2; ++n) for (int k = 0; k < 2; ++k) \
      acc[ai][bj][m][n] = MFMA16(At_[m][k], Bt_[n][k], acc[ai][bj][m][n]); \
    __builtin_amdgcn_s_setprio(0); } while (0)
#define WAIT_V(n) asm volatile("s_waitcnt vmcnt(" #n ")" ::: "memory")
#define WAIT_L(n) asm volatile("s_waitcnt lgkmcnt(" #n ")" ::: "memory")
#define BAR __builtin_amdgcn_s_barrier()
#define SCHED __builtin_amdgcn_sched_barrier(0)

  const int tid = get_tid(WV);
  const int wid = wave_of(tid), lane = tid & 63, wr = wid >> 2, wc = wid & 3, fr = lane & 15, fq = lane >> 4;
  const int sb0 = tid * 16, sb1 = sb0 + 8192;
  int R0, C0; stage_rc(sb0, R0, C0);
  const unsigned offA0 = (unsigned)(R0 * lda + C0) * 2u, offB0 = (unsigned)(R0 * ldb + C0) * 2u;
  const int ac0 = ar0, ac1 = ar1, bb0 = bc0, bb1 = bc0 + HALF;
  bf16x8 At[4][2], B0[2][2], B1[2][2];
  const int nt = K / BK;
  __syncthreads();
  STAGE_B(SB(0, 0), bb0, 0); STAGE_A(SA(0, 0), ac0, 0);
  STAGE_B(SB(0, 1), bb1, 0); STAGE_A(SA(0, 1), ac1, 0);
  if (wr == 1) BAR;
  WAIT_V(4); BAR;
  STAGE_B(SB(1, 0), bb0, 1); STAGE_A(SA(1, 0), ac0, 1); STAGE_B(SB(1, 1), bb1, 1);
  WAIT_V(6); BAR;
  for (int t = 0; t < nt - 2; t += 2) {
    LDB(B0, 0, 0); SCHED; LDA(At, 0, 0); STAGE_A(SA(1, 1), ac1, t + 1);
    WAIT_L(8); BAR; WAIT_L(0); MMA(0, 0, At, B0); BAR; SCHED;
    LDB(B1, 0, 1); STAGE_B(SB(0, 0), bb0, t + 2);
    BAR; WAIT_L(0); MMA(0, 1, At, B1); BAR;
    LDA(At, 0, 1); STAGE_A(SA(0, 0), ac0, t + 2);
    BAR; WAIT_L(0); MMA(1, 0, At, B0); BAR; SCHED;
    STAGE_B(SB(0, 1), bb1, t + 2);
    WAIT_V(6); BAR; MMA(1, 1, At, B1); BAR;
    LDB(B0, 1, 0); SCHED; LDA(At, 1, 0); STAGE_A(SA(0, 1), ac1, t + 2);
    WAIT_L(8); BAR; WAIT_L(0); MMA(0, 0, At, B0); BAR; SCHED;
    LDB(B1, 1, 1); STAGE_B(SB(1, 0), bb0, t + 3);
    BAR; WAIT_L(0); MMA(0, 1, At, B1); BAR;
    LDA(At, 1, 1); STAGE_A(SA(1, 0), ac0, t + 3);
    BAR; WAIT_L(0); MMA(1, 0, At, B0); BAR; SCHED;
    STAGE_B(SB(1, 1), bb1, t + 3);
    WAIT_V(6); BAR; MMA(1, 1, At, B1); BAR;
  }
  { LDB(B0, 0, 0); LDA(At, 0, 0); STAGE_A(SA(1, 1), ac1, nt - 1);
    BAR; WAIT_L(0); MMA(0, 0, At, B0); BAR;
    LDB(B1, 0, 1); BAR; WAIT_L(0); MMA(0, 1, At, B1); BAR;
    LDA(At, 0, 1); WAIT_V(4); BAR; WAIT_L(0); MMA(1, 0, At, B0); MMA(1, 1, At, B1); BAR; }
  { LDB(B0, 1, 0); LDA(At, 1, 0); WAIT_V(2); BAR; WAIT_L(0); MMA(0, 0, At, B0); BAR;
    LDB(B1, 1, 1); WAIT_V(0); BAR; WAIT_L(0); MMA(0, 1, At, B1); BAR;
    LDA(At, 1, 1); BAR; WAIT_L(0); MMA(1, 0, At, B0); MMA(1, 1, At, B1); BAR; }
  if (wr == 0) BAR;
#undef SA
#undef SB
}
template <class Epi>
DI void apply_epi(WVP AccT& acc, int bc0, const Epi& epi) {
  const int t2 = get_tid(WV);
  const int wid2 = wave_of(t2), lane2 = t2 & 63, wr2 = wid2 >> 2, wc2 = wid2 & 3, fr2 = lane2 & 15, fq2 = lane2 >> 4;
  for (int bj = 0; bj < 2; ++bj) for (int m = 0; m < 4; ++m) {
    for (int n = 0; n < 2; ++n)
      epi(acc[0][bj][m][n], acc[1][bj][m][n], wr2 * 64 + m * 16 + fq2 * 4, bc0 + bj * HALF + wc2 * 32 + n * 16 + fr2, bj * 8 + m * 2 + n, t2);
    if (m & 1) __builtin_amdgcn_sched_barrier(0);
  }
}
template <class Epi>
DI void apply_epi_staged(WVP char* smem, AccT& acc, int bc0, const Epi& epi) {
  constexpr int NC = Epi::NC, PITCH = NC * 2 + 16;
  const int t2 = get_tid(WV);
  const int wid2 = wave_of(t2), lane2 = t2 & 63, wr2 = wid2 >> 2, wc2 = wid2 & 3, fr2 = lane2 & 15, fq2 = lane2 >> 4;
  for (int bj = 0; bj < 2; ++bj) for (int m = 0; m < 4; ++m) {
    for (int n = 0; n < 2; ++n) {
      const int rl = wr2 * 64 + m * 16 + fq2 * 4, tc = bj * HALF + wc2 * 32 + n * 16 + fr2;
      f32x4 r0, r1;
      epi.tr(acc[0][bj][m][n], acc[1][bj][m][n], rl, bc0 + tc, bj * 8 + m * 2 + n, t2, r0, r1);
      uint2 v0; v0.x = pack2(r0[0], r0[1]); v0.y = pack2(r0[2], r0[3]);
      *(uint2*)(smem + tc * PITCH + rl * 2) = v0;
      if (NC == 256) { uint2 v1; v1.x = pack2(r1[0], r1[1]); v1.y = pack2(r1[2], r1[3]); *(uint2*)(smem + tc * PITCH + (HALF + rl) * 2) = v1; }
    }
    if (m & 1) __builtin_amdgcn_sched_barrier(0);
  }
  __syncthreads();
  constexpr int CPR = NC / 8;
#pragma unroll
  for (int i = 0; i < 256 * CPR / NTHR; ++i) {
    const int L = i * NTHR + t2, row = L / CPR, ch = L % CPR;
    const u32x4 v = *(const u32x4*)(smem + row * PITCH + ch * 16);
    *(u32x4*)(epi.out(bc0 + row, ch)) = v;
  }
}
template <class Epi>
DI void gemm_tile(WVP char* smem, const u16* __restrict__ A, int lda, int ar0, int ar1,
                  const u16* __restrict__ B, int ldb, int bc0, int K, const Epi& epi) {
  AccT acc = {};
  gemm_core(WV, smem, A, lda, ar0, ar1, B, ldb, bc0, K, acc);
  apply_epi(WV, acc, bc0, epi);
}
template <class Epi>
DI void gemm_tile_staged(WVP char* smem, const u16* __restrict__ A, int lda, int ar0, int ar1,
                  const u16* __restrict__ B, int ldb, int bc0, int K, const Epi& epi) {
  AccT acc = {};
  gemm_core(WV, smem, A, lda, ar0, ar1, B, ldb, bc0, K, acc);
  apply_epi_staged(WV, smem, acc, bc0, epi);
}

DI void tile_map(int id, int nwg, int nR, int nC, int& pr, int& pc) {
  constexpr int NX = 8, WGM = 4;
  int q = nwg / NX, r = nwg % NX, xcd = id % NX, off = id / NX;
  id = (xcd < r ? xcd * (q + 1) : r * (q + 1) + (xcd - r) * q) + off;
  int nig = WGM * nC, gid = id / nig, fm = gid * WGM, gsz = min(nR - fm, WGM);
  pr = fm + ((id % nig) % gsz); pc = (id % nig) / gsz;
}

struct EpiStore2 { static constexpr int NC = 256; u16* dst; int ld; int n0, n1;
  DI void tr(const f32x4& a0, const f32x4& a1, int, int, int, int, f32x4& r0, f32x4& r1) const { r0 = a0; r1 = a1; }
  DI u16* out(int row, int ch) const { return dst + (long)row * ld + (ch < 16 ? n0 + ch * 8 : n1 + (ch - 16) * 8); } };
template <int ACT> struct EpiGated { static constexpr int NC = 128; u16* dst; int ld; int nb;
  DI void tr(const f32x4& a0, const f32x4& a1, int, int, int, int, f32x4& r0, f32x4& r1) const {
    for (int j = 0; j < 4; ++j) r0[j] = ACT == 0 ? siluf_(a0[j]) * a1[j] : a0[j] * sigmoidf_(a1[j]);
    r1 = r0; }
  DI u16* out(int row, int ch) const { return dst + (long)row * ld + nb + ch * 8; } };
struct EpiResid { const float* xin; float* xout; int n0, n1;
  DI void operator()(f32x4& a0, f32x4& a1, int rl, int col, int, int) const {
    f32x4 v0 = *(const f32x4*)(xin + (long)col * DM + n0 + rl), v1 = *(const f32x4*)(xin + (long)col * DM + n1 + rl);
    *(f32x4*)(xout + (long)col * DM + n0 + rl) = v0 + a0; *(f32x4*)(xout + (long)col * DM + n1 + rl) = v1 + a1; } };
DI u16* stash_ptr(u16* base, int ld, int bc0, int j, int tid) { const int L = j * NTHR + tid; return base + (long)(bc0 + (L >> 5)) * ld + (L & 31) * 8; }
DI void unpack8(const u32x4& v, f32x4& lo, f32x4& hi) { lo = f32x4{bflo(v[0]), bfhi(v[0]), bflo(v[1]), bfhi(v[1])}; hi = f32x4{bflo(v[2]), bfhi(v[2]), bflo(v[3]), bfhi(v[3])}; }
struct EpiSig { u16* dst; int ld; int bc0;
  DI void operator()(f32x4& a0, f32x4& a1, int, int, int j, int tid) const {
    f32x4 r0, r1;
    for (int q = 0; q < 4; ++q) { r0[q] = fmaxf(sigmoidf_(a0[q]), 1e-20f); r1[q] = fmaxf(sigmoidf_(a1[q]), 1e-20f); }
    u32x4 v = {pack2(r0[0], r0[1]), pack2(r0[2], r0[3]), pack2(r1[0], r1[1]), pack2(r1[2], r1[3])};
    *(u32x4*)stash_ptr(dst, ld, bc0, j, tid) = v; } };
struct EpiRescale { u16* sc; int ldc; u16* sn; int ldn; int bc0;
  DI void operator()(f32x4& a0, f32x4& a1, int, int, int j, int tid) const {
    const u32x4 vc = *(const u32x4*)stash_ptr(sc, ldc, bc0, j, tid), vn = *(const u32x4*)stash_ptr(sn, ldn, bc0, j, tid);
    f32x4 c0, c1, n0, n1; unpack8(vc, c0, c1); unpack8(vn, n0, n1);
    for (int q = 0; q < 4; ++q) { a0[q] *= c0[q] * frcp(n0[q]); a1[q] *= c1[q] * frcp(n1[q]); } } };
struct EpiFinalGate { static constexpr int NC = 256; u16* mg; int nbase; int bc0;
  DI void tr(const f32x4& a0, const f32x4& a1, int, int, int j, int tid, f32x4& r0, f32x4& r1) const {
    const u32x4 vc = *(const u32x4*)stash_ptr(mg + nbase, DM, bc0, j, tid);
    f32x4 c0, c1; unpack8(vc, c0, c1); r0 = a0 * c0; r1 = a1 * c1; }
  DI u16* out(int row, int ch) const { return mg + (long)row * DM + nbase + ch * 8; } };

typedef unsigned long long u64;
typedef __attribute__((address_space(1))) u64 gu64;
struct EpiNormOut { static constexpr int NC = 256; u16* xn; int n0; const float* g; const float* rsb; int bc0;
  DI void tr(const f32x4& a0, const f32x4& a1, int rl, int col, int, int, f32x4& r0, f32x4& r1) const {
    const float rs = rsb[col - bc0];
    const f32x4 g0 = *(const f32x4*)(g + n0 + rl), g1 = *(const f32x4*)(g + n0 + HALF + rl);
    r0 = a0 * g0 * rs; r1 = a1 * g1 * rs; }
  DI u16* out(int row, int ch) const { return xn + (long)row * DM + n0 + ch * 8; } };
DI void resid_norm_epi(WVP char* smem, AccT& acc, int bc0, const float* xin, float* xout, int n0, int pc, int pr, unsigned epoch,
                       u64* slab, const float* g, u16* xn, bool write_norm) {
  const int t2 = get_tid(WV);
  const int wid2 = wave_of(t2), lane2 = t2 & 63, wr2 = wid2 >> 2, wc2 = wid2 & 3, fr2 = lane2 & 15, fq2 = lane2 >> 4;
  float* part = (float*)(smem + 139264);
  float* rsb = part + 512;
  float sq[2][2] = {{0.f, 0.f}, {0.f, 0.f}};
  for (int bj = 0; bj < 2; ++bj) for (int m = 0; m < 4; ++m) {
    for (int n = 0; n < 2; ++n) {
      const int rl = wr2 * 64 + m * 16 + fq2 * 4, col = bc0 + bj * HALF + wc2 * 32 + n * 16 + fr2;
      const f32x4 v0 = *(const f32x4*)(xin + (long)col * DM + n0 + rl) + acc[0][bj][m][n], v1 = *(const f32x4*)(xin + (long)col * DM + n0 + HALF + rl) + acc[1][bj][m][n];
      *(f32x4*)(xout + (long)col * DM + n0 + rl) = v0; *(f32x4*)(xout + (long)col * DM + n0 + HALF + rl) = v1;
      acc[0][bj][m][n] = v0; acc[1][bj][m][n] = v1;
      sq[bj][n] += v0[0] * v0[0] + v0[1] * v0[1] + v0[2] * v0[2] + v0[3] * v0[3] + v1[0] * v1[0] + v1[1] * v1[1] + v1[2] * v1[2] + v1[3] * v1[3];
    }
    if (m & 1) __builtin_amdgcn_sched_barrier(0);
  }
  for (int bj = 0; bj < 2; ++bj) for (int n = 0; n < 2; ++n) {
    float sv = sq[bj][n]; sv += shflx(sv, 16, lane2); sv += shflx(sv, 32, lane2);
    if (fq2 == 0) part[wr2 * 256 + bj * HALF + wc2 * 32 + n * 16 + fr2] = sv;
  }
  __syncthreads();
  if (t2 < 256) {
    const float tot = part[t2] + part[256 + t2];
    __hip_atomic_store((gu64*)(slab + ((size_t)(pc * 4 + pr) * 256 + t2)), ((u64)epoch << 32) | (u64)__float_as_uint(tot), __ATOMIC_RELAXED, __HIP_MEMORY_SCOPE_AGENT);
    gu64* gb = (gu64*)(slab + ((size_t)(pc * 4) * 256 + t2));
    float sum = 0.f;
    for (unsigned spins = 0;; ++spins) {
      bool ok = true; sum = 0.f;
#pragma unroll
      for (int q = 0; q < 4; ++q) { const u64 x = __hip_atomic_load(gb + q * 256, __ATOMIC_RELAXED, __HIP_MEMORY_SCOPE_AGENT); ok &= (unsigned)(x >> 32) == epoch; sum += __uint_as_float((unsigned)x); }
      if (__all(ok) || spins > (1u << 22)) break;
      __builtin_amdgcn_s_sleep(1);
    }
    rsb[t2] = rsqrtf(sum * (1.f / DM) + 1e-6f);
  }
  __syncthreads();
  if (write_norm) { EpiNormOut E{xn, n0, g, rsb, bc0}; apply_epi_staged(WV, smem, acc, bc0, E); }
}

DI void phase_rmsnorm(WVP const float* __restrict__ x, const float* __restrict__ g, u16* __restrict__ o) {
  const int BID = get_bid(), GRD = get_grid();
  const int tid = get_tid(WV), wave = wave_of(tid), lane = tid & 63;
  f32x4 gv[4];
  for (int i = 0; i < 4; ++i) gv[i] = *(const f32x4*)(g + i * 256 + lane * 4);
  for (int row = BID * 8 + wave; row < TOK; row += GRD * 8) {
    f32x4 v[4]; float ss = 0.f;
    for (int i = 0; i < 4; ++i) { v[i] = *(const f32x4*)(x + (long)row * DM + i * 256 + lane * 4); ss += v[i][0] * v[i][0] + v[i][1] * v[i][1] + v[i][2] * v[i][2] + v[i][3] * v[i][3]; }
    for (int d = 32; d >= 1; d >>= 1) ss += shflx(ss, d, lane);
    float rs = rsqrtf(ss * (1.f / DM) + 1e-6f);
    for (int i = 0; i < 4; ++i) store4bf(o + (long)row * DM + i * 256 + lane * 4, v[i] * rs * gv[i]);
  }
}
DI void phase_final_norm(WVP float* __restrict__ x, const float* __restrict__ g) {
  const int BID = get_bid(), GRD = get_grid();
  const int tid = get_tid(WV), wave = wave_of(tid), lane = tid & 63;
  f32x4 gv[4];
  for (int i = 0; i < 4; ++i) gv[i] = *(const f32x4*)(g + i * 256 + lane * 4);
  for (int row = BID * 8 + wave; row < TOK; row += GRD * 8) {
    f32x4 v[4]; float ss = 0.f;
    for (int i = 0; i < 4; ++i) { v[i] = *(const f32x4*)(x + (long)row * DM + i * 256 + lane * 4); ss += v[i][0] * v[i][0] + v[i][1] * v[i][1] + v[i][2] * v[i][2] + v[i][3] * v[i][3]; }
    for (int d = 32; d >= 1; d >>= 1) ss += shflx(ss, d, lane);
    float rs = rsqrtf(ss * (1.f / DM) + 1e-6f);
    for (int i = 0; i < 4; ++i) *(f32x4*)(x + (long)row * DM + i * 256 + lane * 4) = v[i] * rs * gv[i];
  }
}

DI void transpose_tile(WVP float* sm, const float* __restrict__ src, int lds_, u16* __restrict__ dst, int ldd, int k0, int n0) {
  const int tid = get_tid(WV);
  constexpr int P = 257;
  f32x4 v[8];
  const int rb = tid >> 6, c4 = (tid & 63) * 4;
#pragma unroll
  for (int i = 0; i < 8; ++i) v[i] = *(const f32x4*)(src + (long)(k0 + rb + 8 * i) * lds_ + n0 + c4);
  __syncthreads();
#pragma unroll
  for (int i = 0; i < 8; ++i) for (int j = 0; j < 4; ++j) sm[(rb + 8 * i) * P + c4 + j] = v[i][j];
  __syncthreads();
#pragma unroll
  for (int i = 0; i < 4; ++i) {
    const int c = tid + NTHR * i, n = c >> 3, k8 = (c & 7) * 8;
    u32x4 o;
    o[0] = pack2(sm[(k8 + 0) * P + n], sm[(k8 + 1) * P + n]); o[1] = pack2(sm[(k8 + 2) * P + n], sm[(k8 + 3) * P + n]);
    o[2] = pack2(sm[(k8 + 4) * P + n], sm[(k8 + 5) * P + n]); o[3] = pack2(sm[(k8 + 6) * P + n], sm[(k8 + 7) * P + n]);
    *(u32x4*)(dst + (long)(n0 + n) * ldd + k0 + k8) = o;
  }
}
DI void phase_wprep(WVP CP pp, int l, char* smem) {
  const int BID = get_bid(), GRD = get_grid();
  char* ws = pp->ws;
  float* sm = (float*)smem;
  const float* w_in = pp->in[2] + (size_t)l * DM * INW;
  const float* w_gate = pp->in[16] + (size_t)l * 4 * DM * DM;
  const float* w_branch = pp->in[15] + (size_t)l * 1792 * DM;
  const float* w_out = pp->in[17] + (size_t)l * DM * DM;
  const float* w_up = pp->in[19] + (size_t)l * DM * 2 * FFN;
  const float* w_down = pp->in[20] + (size_t)l * FFN * DM;
  const float* w_glu = pp->in[14] + (size_t)l * 512 * 1024;
  u16* WB = (u16*)(ws + WS_WB);
  constexpr int NJ = 12;
  const float* src[NJ] = {w_in, w_gate, w_gate + DM * DM, w_gate + 2 * DM * DM, w_gate + 3 * DM * DM,
                          w_branch + 512 * DM, w_branch + 768 * DM, w_branch + 1280 * DM, w_out, w_up, w_down, w_glu};
  const int lds_[NJ] = {INW, DM, DM, DM, DM, DM, DM, DM, DM, 2 * FFN, DM, 1024};
  const int Kd[NJ] = {DM, DM, DM, DM, DM, 256, 512, 512, DM, DM, FFN, 512};
  const int Nd[NJ] = {INW, DM, DM, DM, DM, DM, DM, DM, DM, 2 * FFN, DM, 1024};
  u16* dst[NJ] = {(u16*)(ws + WS_WIN), (u16*)(ws + WS_WG), (u16*)(ws + WS_WG) + DM * DM, (u16*)(ws + WS_WG) + 2 * DM * DM, (u16*)(ws + WS_WG) + 3 * DM * DM,
                  WB + DM * 512, WB + DM * 768, WB + DM * 1280, (u16*)(ws + WS_WO), (u16*)(ws + WS_WUP), (u16*)(ws + WS_WDN), (u16*)(ws + WS_WGLU)};
  int base = 0;
#pragma unroll
  for (int j = 0; j < NJ; ++j) {
    int nk = Kd[j] / 64, nn = Nd[j] / 256, cnt = nk * nn;
    int first = (BID - base % GRD + GRD) % GRD;
    for (int i = first; i < cnt; i += GRD) transpose_tile(WV, sm, src[j], lds_[j], dst[j], Kd[j], (i / nn) * 64, (i % nn) * 256);
    base += cnt;
  }
  const float* pool_w = pp->in[3] + (size_t)l * 4 * 128 * 128;
  const float* pool_s = pp->in[4] + (size_t)l * 512;
  for (int it = GRD - 1 - BID; it < 16 * 16; it += GRD) {
    const int k0 = (it >> 4) * 32, n0 = (it & 15) * 64;
    const int tid = get_tid(WV);
    const int n = n0 + (tid & 63), kb = k0 + (tid >> 6) * 4, g = kb >> 7;
    float accv[4] = {0, 0, 0, 0};
    const float* pw = pool_w + (size_t)(g * 128 + (kb & 127)) * 128;
#pragma unroll 2
    for (int d = 0; d < 128; d += 4) {
      const f32x4 ps = *(const f32x4*)(pool_s + g * 128 + d);
      float wv[4];
      for (int q = 0; q < 4; ++q) wv[q] = ps[q] * w_branch[(long)(g * 128 + d + q) * DM + n];
      for (int jj = 0; jj < 4; ++jj) {
        const f32x4 p4 = *(const f32x4*)(pw + jj * 128 + d);
        accv[jj] += p4[0] * wv[0] + p4[1] * wv[1] + p4[2] * wv[2] + p4[3] * wv[3];
      }
    }
    uint2 o; o.x = pack2(accv[0], accv[1]); o.y = pack2(accv[2], accv[3]);
    *(uint2*)(WB + (long)n * 512 + kb) = o;
  }
}

DI void mix_pool(WVP const u16* __restrict__ proj, u16* __restrict__ pb) {
  const int BID = get_bid(), GRD = get_grid();
  const int tid = get_tid(WV);
  for (int idx = BID * NTHR + tid; idx < (TOK / 16) * 64; idx += GRD * NTHR) {
    const int cc = idx & 63, t0 = (idx >> 6) * 16, gi = cc >> 4, w = 2 << gi, s0 = t0 & (SEQ - 1);
    const u16* base = proj + (long)t0 * INW + cc * 8;
    float a[8] = {0, 0, 0, 0, 0, 0, 0, 0};
    for (int i = 1; i < w; ++i) {
      if (s0 - i >= 0) {
        const u32x4 v = *(const u32x4*)(base - (long)i * INW);
        a[0] += bflo(v[0]); a[1] += bfhi(v[0]); a[2] += bflo(v[1]); a[3] += bfhi(v[1]); a[4] += bflo(v[2]); a[5] += bfhi(v[2]); a[6] += bflo(v[3]); a[7] += bfhi(v[3]);
      }
    }
#pragma unroll 4
    for (int k = 0; k < 16; ++k) {
      const int s = s0 + k;
      const u32x4 v = *(const u32x4*)(base + (long)k * INW);
      float u[8] = {bflo(v[0]), bfhi(v[0]), bflo(v[1]), bfhi(v[1]), bflo(v[2]), bfhi(v[2]), bflo(v[3]), bfhi(v[3])};
      for (int q = 0; q < 8; ++q) a[q] += u[q];
      const float ic = 1.f / (float)min(w, s + 1);
      u32x4 o;
      o[0] = pack2(a[0] * ic - u[0], a[1] * ic - u[1]); o[1] = pack2(a[2] * ic - u[2], a[3] * ic - u[3]);
      o[2] = pack2(a[4] * ic - u[4], a[5] * ic - u[5]); o[3] = pack2(a[6] * ic - u[6], a[7] * ic - u[7]);
      *(u32x4*)(pb + (long)(t0 + k) * 512 + cc * 8) = o;
      if (s - w + 1 >= 0) {
        const u32x4 x = *(const u32x4*)(base + (long)(k - w + 1) * INW);
        a[0] -= bflo(x[0]); a[1] -= bfhi(x[0]); a[2] -= bflo(x[1]); a[3] -= bfhi(x[1]); a[4] -= bflo(x[2]); a[5] -= bfhi(x[2]); a[6] -= bflo(x[3]); a[7] -= bfhi(x[3]);
      }
    }
  }
}

DI int t5_bucket(int dist) {
  if (dist < 16) return dist;
  const int thr[15] = {22, 30, 40, 54, 73, 99, 134, 182, 246, 332, 450, 609, 825, 1117, 1513};
  int b = 16;
#pragma unroll
  for (int k = 0; k < 15; ++k) b += (dist >= thr[k]) ? 1 : 0;
  return b;
}
DI void mix_dil(WVP u16* __restrict__ proj, float* __restrict__ lse, const float* __restrict__ rel_bias, char* smem) {
  const int BID = get_bid(), GRD = get_grid();
  const int tid = get_tid(WV), wave = wave_of(tid), lane = tid & 63, h = lane >> 5, l31 = lane & 31;
  float* btab = (float*)smem;
  char* vbuf = smem + 12 * 132 * 4 + wave * 4608;
  __syncthreads();
  for (int i = tid; i < 12 * 129; i += NTHR) {
    int H = i / 129, ds = i % 129, g = H >> 2; int dil = g == 0 ? 1 : (g == 1 ? 4 : 16);
    btab[H * 132 + ds] = rel_bias[t5_bucket(ds * dil) * 12 + H] * 1.44269504089f;
  }
  __syncthreads();
  const float sc = 1.44269504089f * 0.125f;
  const int i16 = lane & 15, tq = i16 >> 2, tp = i16 & 3, blk = (lane >> 4) & 1;
#define DIL_DECODE(u_, tb_, q0_, H_, dil_, j0_) \
    const int v_ = (u_) & 127, hh_ = ((u_) >> 7) & 3, g_ = ((u_) >> 9) % 3, b_ = (u_) / (512 * 3); \
    const int dsh_ = g_ * 2; dil_ = 1 << dsh_; const int nq_ = (SEQ >> dsh_) >> 5; \
    const int r_ = v_ / nq_; q0_ = (v_ % nq_) * 32; H_ = g_ * 4 + hh_; tb_ = (long)b_ * SEQ + r_; j0_ = q0_ >= 128 ? 0 : (128 - q0_) >> 5;
  bf16x8 bq_n[4], ak_n[4]; u32x4 vv_n[4];
  const int u_first = BID * 8 + wave, u_step = GRD * 8, u_end = BATCH * 3 * 4 * 128;
  if (u_first < u_end) {
    long tb; int q0, H, dil, j0; DIL_DECODE(u_first, tb, q0, H, dil, j0)
    const u16* qp = proj + (tb + (long)(q0 + l31) * dil) * INW + O1 + H * 64;
    for (int s = 0; s < 4; ++s) bq_n[s] = *(const bf16x8*)(qp + 16 * s + 8 * h);
    const u16* kp = proj + (tb + (long)(q0 - 128 + 32 * j0 + l31) * dil) * INW + O1 + 768 + H * 64;
    for (int s = 0; s < 4; ++s) ak_n[s] = *(const bf16x8*)(kp + 16 * s + 8 * h);
    for (int c = 0; c < 4; ++c) vv_n[c] = *(const u32x4*)(kp + 768 + h * 32 + c * 8);
  }
#pragma nounroll
  for (int u = u_first; u < u_end; u += u_step) {
    long tbase; int q0, H, dil, j0; DIL_DECODE(u, tbase, q0, H, dil, j0)
    u16* qp = proj + (tbase + (long)(q0 + l31) * dil) * INW + O1 + H * 64;
    bf16x8 bq[4];
    for (int s = 0; s < 4; ++s) bq[s] = bq_n[s];
    f32x16 O[2]; for (int e = 0; e < 2; ++e) for (int i = 0; i < 16; ++i) O[e][i] = 0.f;
    float mrun = -1e30f, lsum = 0.f;
    const float* bt = btab + H * 132;
    const u16* kbase_ = proj + tbase * INW + O1 + 768 + H * 64;
    f32x16 sacc; for (int i = 0; i < 16; ++i) sacc[i] = 0.f;
    for (int s = 0; s < 4; ++s) sacc = MFMA32(ak_n[s], bq[s], sacc);
    u32x4 vv[4];
    for (int c = 0; c < 4; ++c) vv[c] = vv_n[c];
    if (j0 + 1 < 5) {
      const u16* kp = kbase_ + (long)(q0 - 128 + 32 * (j0 + 1) + l31) * dil * INW;
      for (int s = 0; s < 4; ++s) ak_n[s] = *(const bf16x8*)(kp + 16 * s + 8 * h);
      for (int c = 0; c < 4; ++c) vv_n[c] = *(const u32x4*)(kp + 768 + h * 32 + c * 8);
    }
#pragma nounroll
    for (int j = j0; j < 5; ++j) {
      const int kb = q0 - 128 + 32 * j;
      for (int c = 0; c < 4; ++c) *(u32x4*)(vbuf + l31 * 144 + h * 64 + c * 16) = vv[c];
      f32x16 snx; for (int i = 0; i < 16; ++i) snx[i] = 0.f;
      if (j + 1 < 5) {
        for (int s = 0; s < 4; ++s) snx = MFMA32(ak_n[s], bq[s], snx);
        for (int c = 0; c < 4; ++c) vv[c] = vv_n[c];
        if (j + 2 < 5) {
          const u16* kp = kbase_ + (long)(kb + 64 + l31) * dil * INW;
          for (int s = 0; s < 4; ++s) ak_n[s] = *(const bf16x8*)(kp + 16 * s + 8 * h);
          for (int c = 0; c < 4; ++c) vv_n[c] = *(const u32x4*)(kp + 768 + h * 32 + c * 8);
        }
      }
      if (j == 4 && u + u_step < u_end) {
        long tb2; int q02, H2, dil2, j02; DIL_DECODE(u + u_step, tb2, q02, H2, dil2, j02)
        const u16* qp2 = proj + (tb2 + (long)(q02 + l31) * dil2) * INW + O1 + H2 * 64;
        for (int s = 0; s < 4; ++s) bq_n[s] = *(const bf16x8*)(qp2 + 16 * s + 8 * h);
        const u16* kp = proj + (tb2 + (long)(q02 - 128 + 32 * j02 + l31) * dil2) * INW + O1 + 768 + H2 * 64;
        for (int s = 0; s < 4; ++s) ak_n[s] = *(const bf16x8*)(kp + 16 * s + 8 * h);
        for (int c = 0; c < 4; ++c) vv_n[c] = *(const u32x4*)(kp + 768 + h * 32 + c * 8);
      }
      float mx = -1e30f;
      for (int i = 0; i < 16; ++i) {
        int dist = (q0 + l31) - (kb + crow(i, h));
        bool ok = (dist >= 0) && (dist <= 128);
        int di = min(max(dist, 0), 128);
        float s2 = sacc[i] * sc + bt[di];
        s2 = ok ? s2 : -1e30f;
        sacc[i] = s2; mx = fmaxf(mx, s2);
      }
      mx = fmaxf(mx, shflx(mx, 32, lane));
      float mnew = fmaxf(mrun, mx);
      float alpha = fexp2(mrun - mnew);
      float ps = 0.f;
      for (int i = 0; i < 16; ++i) { float pv = sacc[i] > -1e29f ? fexp2(sacc[i] - mnew) : 0.f; sacc[i] = pv; ps += pv; }
      lsum = lsum * alpha + ps; mrun = mnew;
      for (int e = 0; e < 2; ++e) for (int i = 0; i < 16; ++i) O[e][i] *= alpha;
      __builtin_amdgcn_wave_barrier();
      for (int s = 0; s < 2; ++s) {
        bf16x8 pf = packP(sacc, s);
        for (int e = 0; e < 2; ++e) {
          s16x4 lo = tr_read(vbuf + (16 * s + 4 * h + tq) * 144 + e * 64 + 32 * blk + 8 * tp);
          s16x4 hi = tr_read(vbuf + (16 * s + 8 + 4 * h + tq) * 144 + e * 64 + 32 * blk + 8 * tp);
          bf16x8 av = __builtin_shufflevector(lo, hi, 0, 1, 2, 3, 4, 5, 6, 7);
          O[e] = MFMA32(av, pf, O[e]);
        }
      }
      __builtin_amdgcn_wave_barrier();
      sacc = snx;
    }
    float ltot = lsum + shflx(lsum, 32, lane);
    float inv = 1.f / ltot;
    for (int e = 0; e < 2; ++e) for (int gq = 0; gq < 4; ++gq) {
      f32x4 o4 = {O[e][4 * gq] * inv, O[e][4 * gq + 1] * inv, O[e][4 * gq + 2] * inv, O[e][4 * gq + 3] * inv};
      store4bf(qp + 32 * e + 8 * gq + 4 * h, o4);
    }
    if (h == 0) lse[(tbase + (long)(q0 + l31) * dil) * 12 + H] = (mrun + flog2(ltot)) * 0.6931471805599453f;
  }
}

DI void mix_dil_merge(WVP u16* __restrict__ proj, const float* __restrict__ lse) {
  const int BID = get_bid(), GRD = get_grid();
  const int tid = get_tid(WV);
  for (long idx = (long)BID * NTHR + tid; idx < (long)TOK * 32; idx += (long)GRD * NTHR) {
    int c8 = (int)(idx & 7), j = (int)(idx >> 3) & 3; long tok = idx >> 5;
    float l0 = lse[tok * 12 + j], l1 = lse[tok * 12 + 4 + j], l2 = lse[tok * 12 + 8 + j];
    float m = fmaxf(l0, fmaxf(l1, l2));
    float e0 = __expf(l0 - m), e1 = __expf(l1 - m), e2 = __expf(l2 - m), inv = 1.f / (e0 + e1 + e2);
    e0 *= inv; e1 *= inv; e2 *= inv;
    u16* base = proj + tok * INW + O1 + j * 64 + c8 * 8;
    uint4 a = *(const uint4*)base, b = *(const uint4*)(base + 256), c = *(const uint4*)(base + 512), o;
    o.x = pack2(e0 * bflo(a.x) + e1 * bflo(b.x) + e2 * bflo(c.x), e0 * bfhi(a.x) + e1 * bfhi(b.x) + e2 * bfhi(c.x));
    o.y = pack2(e0 * bflo(a.y) + e1 * bflo(b.y) + e2 * bflo(c.y), e0 * bfhi(a.y) + e1 * bfhi(b.y) + e2 * bfhi(c.y));
    o.z = pack2(e0 * bflo(a.z) + e1 * bflo(b.z) + e2 * bflo(c.z), e0 * bfhi(a.z) + e1 * bfhi(b.z) + e2 * bfhi(c.z));
    o.w = pack2(e0 * bflo(a.w) + e1 * bflo(b.w) + e2 * bflo(c.w), e0 * bfhi(a.w) + e1 * bfhi(b.w) + e2 * bfhi(c.w));
    *(uint4*)base = o;
  }
}

DI void mix_sb(WVP u16* __restrict__ proj, char* smem) {
  const int BID = get_bid(), GRD = get_grid();
  const int tid = get_tid(WV), wave = wave_of(tid), lane = tid & 63, h = lane >> 5, l31 = lane & 31;
  constexpr int RS = 272, TB = 32 * RS;
  char* kbuf = smem; char* vbuf = smem + 2 * TB; int* flags = (int*)(smem + 4 * TB);
  const int i16 = lane & 15, tq = i16 >> 2, tp = i16 & 3, blk = (lane >> 4) & 1;
  const float sc = 1.44269504089f * 0.08838834764831845f;
  const float RTH = -60.f;
  const int lrow = tid >> 4, lch = tid & 15;
  for (int it = BID; it < BATCH * 4 * 16; it += GRD) {
    int qb = 15 - (it & 15), hh = (it >> 4) & 3, b = it >> 6;
    int Q0 = qb * 256;
    u16* base = proj + (long)b * SEQ * INW + O2 + hh * 128;
    u16* qp = base + (long)(Q0 + 32 * wave + l31) * INW;
    bf16x8 bq[8];
    for (int s = 0; s < 8; ++s) bq[s] = *(const bf16x8*)(qp + 16 * s + 8 * h);
    f32x16 O[4]; for (int e = 0; e < 4; ++e) for (int i = 0; i < 16; ++i) O[e][i] = 0.f;
    float R = 0.f;
    const int kt_hi = Q0 / 32 + 7, kt_diag = Q0 / 32 + wave;
    __syncthreads();
    if (tid < 16) flags[tid] = 0;
    {
      const u16* kp = base + 512 + (long)(kt_hi * 32 + lrow) * INW + lch * 8;
      uint4 kv = *(const uint4*)kp, vv = *(const uint4*)(kp + 512);
      *(uint4*)(kbuf + lrow * RS + lch * 16) = kv; *(uint4*)(vbuf + lrow * RS + lch * 16) = vv;
    }
    __syncthreads();
    int cur = 0, iter = 0;
    for (int kt = kt_hi; kt >= 0; --kt, ++iter) {
      uint4 kv, vv;
      const bool more = kt > 0;
      if (more) { const u16* kp = base + 512 + (long)((kt - 1) * 32 + lrow) * INW + lch * 8; kv = *(const uint4*)kp; vv = *(const uint4*)(kp + 512); }
      bool wdone = false;
      if (kt <= kt_diag) {
        const char* kb_ = kbuf + cur * TB; const char* vb_ = vbuf + cur * TB;
        f32x16 sacc; for (int i = 0; i < 16; ++i) sacc[i] = 0.f;
        for (int s = 0; s < 8; ++s) { bf16x8 ak = *(const bf16x8*)(kb_ + l31 * RS + 32 * s + 16 * h); sacc = MFMA32(ak, bq[s], sacc); }
        const bool diag = (kt == kt_diag);
        float ls[16];
        for (int i = 0; i < 16; ++i) {
          float z2 = sacc[i] * sc;
          float sp = fmaxf(z2, 0.f) + flog2(1.f + fexp2(-fabsf(z2)));
          bool ok = !diag || (crow(i, h) < l31);
          ls[i] = ok ? -sp : 0.f;
          sacc[i] = ok ? z2 : -1e30f;
        }
        float G[4], Gp[4], tot[4];
        for (int g = 0; g < 4; ++g) G[g] = (ls[4 * g] + ls[4 * g + 1]) + (ls[4 * g + 2] + ls[4 * g + 3]);
        for (int g = 0; g < 4; ++g) { Gp[g] = shflx(G[g], 32, lane); tot[g] = G[g] + Gp[g]; }
        float after = 0.f;
        for (int g = 3; g >= 0; --g) {
          float tail = R + after + (h == 0 ? Gp[g] : 0.f);
          float c3 = tail + ls[4 * g + 3], c2 = c3 + ls[4 * g + 2], c1 = c2 + ls[4 * g + 1], c0 = c1 + ls[4 * g];
          sacc[4 * g + 3] = fexp2(sacc[4 * g + 3] + c3); sacc[4 * g + 2] = fexp2(sacc[4 * g + 2] + c2);
          sacc[4 * g + 1] = fexp2(sacc[4 * g + 1] + c1); sacc[4 * g] = fexp2(sacc[4 * g] + c0);
          after += tot[g];
        }
        R += after;
        for (int s = 0; s < 2; ++s) {
          bf16x8 pf = packP(sacc, s);
          for (int e = 0; e < 4; ++e) {
            s16x4 lo = tr_read(vb_ + (16 * s + 4 * h + tq) * RS + e * 64 + 32 * blk + 8 * tp);
            s16x4 hi = tr_read(vb_ + (16 * s + 8 + 4 * h + tq) * RS + e * 64 + 32 * blk + 8 * tp);
            bf16x8 av = __builtin_shufflevector(lo, hi, 0, 1, 2, 3, 4, 5, 6, 7);
            O[e] = MFMA32(av, pf, O[e]);
          }
        }
        wdone = __all(R < RTH);
      }
      if (lane == 0) flags[(iter & 1) * 8 + wave] = wdone ? 1 : 0;
      if (more) { *(uint4*)(kbuf + (cur ^ 1) * TB + lrow * RS + lch * 16) = kv; *(uint4*)(vbuf + (cur ^ 1) * TB + lrow * RS + lch * 16) = vv; }
      __syncthreads();
      cur ^= 1;
      int nd = 0;
      for (int w2 = 0; w2 < 8; ++w2) nd += flags[(iter & 1) * 8 + w2];
      if (nd == 8) break;
    }
    for (int e = 0; e < 4; ++e) for (int gq = 0; gq < 4; ++gq) {
      f32x4 o4 = {O[e][4 * gq], O[e][4 * gq + 1], O[e][4 * gq + 2], O[e][4 * gq + 3]};
      store4bf(qp + 32 * e + 8 * gq + 4 * h, o4);
    }
  }
}

DI void mix_s5(WVP CP pp, int l, u16* __restrict__ proj, char* smem) {
  const int BID = get_bid(), GRD = get_grid();
  const int tid = get_tid(WV), wave = wave_of(tid), lane = tid & 63, h = lane >> 5, l31 = lane & 31;
  constexpr int RSF = 132;
  float* buf = (float*)smem + wave * 32 * RSF;
  float* hend = (float*)(smem + 8 * 32 * RSF * 4);
  for (int it = BID; it < BATCH * 32; it += GRD) {
    const int g = it & 31, b = it >> 5;
    const float* a_re = pp->in[6] + ((size_t)l * 32 + g) * 64;
    const float* a_im = pp->in[7] + ((size_t)l * 32 + g) * 64;
    const float dt = __expf(pp->in[8][l * 32 + g]);
    const float* b_re = pp->in[9] + ((size_t)l * 32 + g) * 64 * 16;
    const float* b_im = pp->in[10] + ((size_t)l * 32 + g) * 64 * 16;
    const float* c_re = pp->in[11] + ((size_t)l * 32 + g) * 16 * 64;
    const float* c_im = pp->in[12] + ((size_t)l * 32 + g) * 16 * 64;
    const float* dsk = pp->in[13] + (size_t)l * 512 + g * 16;
    float lr, li;
    { float ar = a_re[lane], ai = a_im[lane]; float mg = expf(ar * dt); float sn, cs; sincosf(ai * dt, &sn, &cs); lr = mg * cs; li = mg * sn; }
    bf16x8 bfrag[4];
    float lam_r[2], lam_i[2];
    for (int half = 0; half < 2; ++half) {
      int ps = 32 * half + l31;
      float ar = a_re[ps], ai = a_im[ps]; float mg = expf(ar * dt); float sn, cs; sincosf(ai * dt, &sn, &cs);
      lam_r[half] = mg * cs; lam_i[half] = mg * sn;
      float xr = mg * cs - 1.f, xi = mg * sn, den = 1.f / (ar * ar + ai * ai);
      float cr = (xr * ar + xi * ai) * den, ci = (xi * ar - xr * ai) * den;
      float vr[8], vi[8];
      for (int j = 0; j < 8; ++j) { float br = b_re[ps * 16 + 8 * h + j], bi = b_im[ps * 16 + 8 * h + j]; vr[j] = cr * br - ci * bi; vi[j] = cr * bi + ci * br; }
      uint4 a = {pack2(vr[0], vr[1]), pack2(vr[2], vr[3]), pack2(vr[4], vr[5]), pack2(vr[6], vr[7])};
      uint4 c = {pack2(vi[0], vi[1]), pack2(vi[2], vi[3]), pack2(vi[4], vi[5]), pack2(vi[6], vi[7])};
      bfrag[half] = __builtin_bit_cast(bf16x8, a); bfrag[2 + half] = __builtin_bit_cast(bf16x8, c);
    }
    bf16x8 cfrag[4];
    { int c = lane & 15, kq = lane >> 4;
      for (int s = 0; s < 4; ++s) {
        float v[8];
        for (int j = 0; j < 8; ++j) { int k = 32 * s + 8 * kq + j; v[j] = k < 64 ? c_re[c * 64 + k] : -c_im[c * 64 + k - 64]; }
        uint4 a = {pack2(v[0], v[1]), pack2(v[2], v[3]), pack2(v[4], v[5]), pack2(v[6], v[7])};
        cfrag[s] = __builtin_bit_cast(bf16x8, a);
      } }
    const float dskip = dsk[lane & 15];
    u16* ub = proj + ((long)b * SEQ + wave * 512) * INW + O3 + g * 16;
    float hr = 0.f, hi = 0.f;
    __syncthreads();
    if (wave < 7) {
      float Hr[2] = {0.f, 0.f}, Hi[2] = {0.f, 0.f};
      float wre[2][16], wim[2][16], l32r[2], l32i[2];
      for (int half = 0; half < 2; ++half) {
        const float ar = lam_r[half], ai = lam_i[half];
        const float l2r = ar * ar - ai * ai, l2i = 2.f * ar * ai;
        const float l4r = l2r * l2r - l2i * l2i, l4i = 2.f * l2r * l2i;
        const float l5r = l4r * ar - l4i * ai, l5i = l4r * ai + l4i * ar;
        const float l8r = l4r * l4r - l4i * l4i, l8i = 2.f * l4r * l4i;
        const float l16r = l8r * l8r - l8i * l8i, l16i = 2.f * l8r * l8i;
        l32r[half] = l16r * l16r - l16i * l16i; l32i[half] = 2.f * l16r * l16i;
        float cr = h ? 1.f : l4r, ci = h ? 0.f : l4i;
#pragma unroll
        for (int i = 15; i >= 0; --i) {
          wre[half][i] = cr; wim[half][i] = ci;
          const float mr = (i & 3) ? ar : l5r, mi = (i & 3) ? ai : l5i;
          const float nr = cr * mr - ci * mi, ni = cr * mi + ci * mr; cr = nr; ci = ni;
        }
      }
      bf16x8 au_n = *(const bf16x8*)(ub + (long)l31 * INW + 8 * h);
      f32x16 z; for (int i = 0; i < 16; ++i) z[i] = 0.f;
#pragma nounroll
      for (int ch = 0; ch < 16; ++ch) {
        const bf16x8 au = au_n;
        if (ch + 1 < 16) au_n = *(const bf16x8*)(ub + (long)((ch + 1) * 32 + l31) * INW + 8 * h);
#pragma unroll
        for (int half = 0; half < 2; ++half) {
          const f32x16 bre = MFMA32(au, bfrag[half], z), bim = MFMA32(au, bfrag[2 + half], z);
          float sr = 0.f, si = 0.f;
#pragma unroll
          for (int i = 0; i < 16; ++i) { sr += wre[half][i] * bre[i] - wim[half][i] * bim[i]; si += wre[half][i] * bim[i] + wim[half][i] * bre[i]; }
          sr += shflx(sr, 32, lane); si += shflx(si, 32, lane);
          const float nr = l32r[half] * Hr[half] - l32i[half] * Hi[half] + sr, ni = l32r[half] * Hi[half] + l32i[half] * Hr[half] + si;
          Hr[half] = nr; Hi[half] = ni;
        }
      }
      if (h == 0) {
        hend[wave * 128 + l31] = Hr[0]; hend[wave * 128 + 64 + l31] = Hi[0];
        hend[wave * 128 + 32 + l31] = Hr[1]; hend[wave * 128 + 96 + l31] = Hi[1];
      }
    }
    __syncthreads();
    for (int pass = 1; pass < 2; ++pass) {
      if (pass == 1) {
        float pr_ = lr, pi_ = li;
        for (int k = 0; k < 9; ++k) { float nr = pr_ * pr_ - pi_ * pi_, ni = 2.f * pr_ * pi_; pr_ = nr; pi_ = ni; }
        hr = 0.f; hi = 0.f;
        for (int v = 0; v < wave; ++v) { float er = hend[v * 128 + lane], ei = hend[v * 128 + 64 + lane]; float nr = pr_ * hr - pi_ * hi + er, ni = pr_ * hi + pi_ * hr + ei; hr = nr; hi = ni; }
      }
      if (pass == 1 || wave < 7) {
        const int cch = lane & 15, kqq = lane >> 4;
        bf16x8 au_n = *(const bf16x8*)(ub + (long)l31 * INW + 8 * h);
        u16 us_n[8] = {0, 0, 0, 0, 0, 0, 0, 0};
        if (pass == 1) for (int q = 0; q < 8; ++q) us_n[q] = ub[(long)(16 * (q >> 2) + 4 * kqq + (q & 3)) * INW + cch];
#pragma nounroll
        for (int ch = 0; ch < 16; ++ch) {
          u16* up = ub + (long)(ch * 32) * INW;
          const bf16x8 au = au_n;
          u16 us[8];
          for (int q = 0; q < 8; ++q) us[q] = us_n[q];
          if (ch + 1 < 16) {
            const u16* un = up + (long)32 * INW;
            au_n = *(const bf16x8*)(un + (long)l31 * INW + 8 * h);
            if (pass == 1) for (int q = 0; q < 8; ++q) us_n[q] = un[(long)(16 * (q >> 2) + 4 * kqq + (q & 3)) * INW + cch];
          }
          f32x16 z; for (int i = 0; i < 16; ++i) z[i] = 0.f;
          for (int nt = 0; nt < 4; ++nt) {
            f32x16 bu = MFMA32(au, bfrag[nt], z);
            for (int i = 0; i < 16; ++i) buf[crow(i, h) * RSF + (nt >> 1) * 64 + (nt & 1) * 32 + l31] = bu[i];
          }
          __builtin_amdgcn_wave_barrier();
          {
            float sre[32], sim[32];
#pragma unroll
            for (int t = 0; t < 32; ++t) { sre[t] = buf[t * RSF + lane]; sim[t] = buf[t * RSF + 64 + lane]; }
#pragma unroll
            for (int t = 0; t < 32; ++t) {
              float nr = lr * hr - li * hi + sre[t], ni = lr * hi + li * hr + sim[t]; hr = nr; hi = ni; sre[t] = hr; sim[t] = hi;
            }
            if (pass == 1) {
#pragma unroll
              for (int t = 0; t < 32; ++t) { buf[t * RSF + lane] = sre[t]; buf[t * RSF + 64 + lane] = sim[t]; }
            }
          }
          __builtin_amdgcn_wave_barrier();
          if (pass == 1) {
            for (int mt = 0; mt < 2; ++mt) {
              f32x4 y = {0.f, 0.f, 0.f, 0.f};
              for (int s2 = 0; s2 < 4; ++s2) {
                const float* hp = buf + (16 * mt + cch) * RSF + 32 * s2 + 8 * kqq;
                f32x4 x0 = *(const f32x4*)hp, x1 = *(const f32x4*)(hp + 4);
                uint4 a = {pack2(x0[0], x0[1]), pack2(x0[2], x0[3]), pack2(x1[0], x1[1]), pack2(x1[2], x1[3])};
                y = MFMA16(__builtin_bit_cast(bf16x8, a), cfrag[s2], y);
              }
              for (int j = 0; j < 4; ++j) {
                int t = 16 * mt + 4 * kqq + j;
                float yv = y[j] + dskip * bf2f(us[4 * mt + j]);
                up[(long)t * INW + cch] = f2bf(gelu_tanh(yv));
              }
            }
            __builtin_amdgcn_wave_barrier();
          }
        }
      }
      if (pass == 0) { hend[wave * 128 + lane] = hr; hend[wave * 128 + 64 + lane] = hi; __syncthreads(); }
    }
    __syncthreads();
  }
}


#define XB_TMO      128
#define XB_XCNT(j)  (256  + 64 * (j))
#define XB_XSUB(j)  (1280 + 64 * (j))
#define XB_XGEN(j)  (2304 + 64 * (j))
#define XB_TOP      3328
#define XB_TOPGEN   3392
#define XCD_BAR_WORDS 3456
#define XB_SPIN_CAP (1u << 22)
DI unsigned xb_ld(unsigned* p)              { return __hip_atomic_load(p, __ATOMIC_RELAXED, __HIP_MEMORY_SCOPE_AGENT); }
DI unsigned xb_add(unsigned* p, unsigned v) { return __hip_atomic_fetch_add(p, v, __ATOMIC_RELAXED, __HIP_MEMORY_SCOPE_AGENT); }
DI unsigned xb_xcc_id() { return (unsigned)__builtin_amdgcn_s_getreg((3 << 11) | 20) & 0xFu; }
#define XB_SPIN(cond, bar) do { unsigned _sp = 0; while (cond) { __builtin_amdgcn_s_sleep(1); \
    if ((++_sp & 255u) == 0u) { if (xb_ld(&(bar)[XB_TMO])) break; if (_sp > XB_SPIN_CAP) { atomicAdd(&(bar)[XB_TMO], 1u); break; } } } } while (0)
struct XcdBarrier { unsigned* bar; unsigned x; volatile LAS unsigned* st; };
DI XcdBarrier xcd_barrier_post(unsigned* bar, volatile LAS unsigned* st) {
  XcdBarrier b; b.bar = bar; b.x = xb_xcc_id(); b.st = st;
  if (threadIdx.x == 0) (void)xb_add(&bar[XB_XCNT(b.x)], 1u);
  return b;
}
DI void xcd_barrier_complete(unsigned* bar, unsigned x, unsigned& nloc, unsigned& nx) {
  const unsigned G = gridDim.x * gridDim.y * gridDim.z;
  unsigned sum, cnt, mine, sp = 0u;
  for (;;) {
    sum = 0u; cnt = 0u; mine = 0u;
#pragma unroll
    for (unsigned j = 0; j < 16; ++j) { const unsigned c = xb_ld(&bar[XB_XCNT(j)]); sum += c; cnt += (c > 0u) ? 1u : 0u; mine = (j == x) ? c : mine; }
    if (sum == G) break;
    __builtin_amdgcn_s_sleep(1);
    if ((++sp & 255u) == 0u) { if (xb_ld(&bar[XB_TMO])) break; if (sp > XB_SPIN_CAP) { atomicAdd(&bar[XB_TMO], 1u); break; } }
  }
  nloc = mine > 0u ? mine : 1u; nx = cnt > 0u ? cnt : 1u;
}
DI void xcd_barrier(const XcdBarrier& b) {
  asm volatile("s_waitcnt vmcnt(0)" ::: "memory");
  __syncthreads();
  if (threadIdx.x == 0) {
    unsigned* bar = b.bar;
    __builtin_amdgcn_s_waitcnt(0);
    unsigned nloc = b.st[0], nx = b.st[1];
    if (nloc == 0u) { xcd_barrier_complete(bar, b.x, nloc, nx); b.st[0] = nloc; b.st[1] = nx; }
    const unsigned old = xb_add(&bar[XB_XSUB(b.x)], 1u);
    const unsigned gen = old / nloc;
    if (old + 1u == (gen + 1u) * nloc) {
      __builtin_amdgcn_fence(__ATOMIC_RELEASE, "agent");
      asm volatile("s_waitcnt vmcnt(0)" ::: "memory");
      const unsigned og = xb_add(&bar[XB_TOP], 1u);
      const unsigned tg = og / nx;
      if (og + 1u == (tg + 1u) * nx) xb_add(&bar[XB_TOPGEN], 1u);
      else XB_SPIN(xb_ld(&bar[XB_TOPGEN]) == tg, bar);
      __builtin_amdgcn_fence(__ATOMIC_ACQUIRE, "agent");
      xb_add(&bar[XB_XGEN(b.x)], 1u);
      asm volatile("s_waitcnt vmcnt(0)" ::: "memory");
    } else {
      XB_SPIN(xb_ld(&bar[XB_XGEN(b.x)]) == gen, bar);
      __builtin_amdgcn_fence(__ATOMIC_ACQUIRE, "agent");
      asm volatile("s_waitcnt vmcnt(0)" ::: "memory");
    }
  }
  __syncthreads();
}

__global__ void __launch_bounds__(NTHR) mega(Params p) {
  extern __shared__ __attribute__((aligned(16))) char smem[];

  const int ph_lo = p.ph_lo, ph_hi = p.ph_hi;
  const int WV = __builtin_amdgcn_readfirstlane(threadIdx.x >> 6);
  volatile LAS unsigned* xst = (volatile LAS unsigned*)(smem + LDS_BYTES - 16);
  if (threadIdx.x == 0) { xst[0] = 0u; xst[1] = 0u; }
  __syncthreads();
  (void)xcd_barrier_post((unsigned*)(p.ws + WS_BAR), xst);
  for (int ph = ph_lo; ph < ph_hi; ++ph) {
    if (ph != N_PHASES - 1 && ph % PH_PER_LAYER == 6) continue;
    if (ph == ph_lo + 1) cg::this_grid().sync();
    else if (ph > ph_lo) {
      CP pb_ = (CP)__builtin_amdgcn_kernarg_segment_ptr(); asm volatile("" : "+s"(pb_));
      XcdBarrier xbar; xbar.bar = (unsigned*)(pb_->ws + WS_BAR); xbar.x = xb_xcc_id(); xbar.st = (volatile LAS unsigned*)(smem + LDS_BYTES - 16);
      xcd_barrier(xbar);
    }
    const int BID = get_bid(), G = get_grid();
    CP pp = (CP)__builtin_amdgcn_kernarg_segment_ptr(); asm volatile("" : "+s"(pp));
    char* ws = pp->ws;
    u16* proj = (u16*)(ws + WS_PROJ);
    u16* xn = (u16*)(ws + WS_XN);
    u16* pb = (u16*)(ws + WS_PB);
    u16* mg = (u16*)(ws + WS_MG);
    float* lse = (float*)(ws + WS_LSE);
    u16* hbuf = proj;
    const u16* WIN = (const u16*)(ws + WS_WIN); const u16* WG = (const u16*)(ws + WS_WG); const u16* WB = (const u16*)(ws + WS_WB);
    const u16* WO = (const u16*)(ws + WS_WO); const u16* WUP = (const u16*)(ws + WS_WUP); const u16* WDN = (const u16*)(ws + WS_WDN);
    const u16* WGLU = (const u16*)(ws + WS_WGLU);
    float* xres = pp->out;
    const int l = ph / PH_PER_LAYER, k = ph % PH_PER_LAYER;
    if (ph == N_PHASES - 1) { phase_final_norm(WV, xres, pp->in[21]); continue; }
    const float* xin = (l == 0) ? pp->in[0] : xres;
    switch (k) {
      case 0: {
        if (l == 0) phase_rmsnorm(WV, xin, pp->in[1] + (size_t)l * DM, xn);
        phase_wprep(WV, pp, l, smem);
      } break;
      case 1: {
        const int nR = INW / 256, nC = TOK / 256, nwg = nR * nC;
        for (int id = BID; id < nwg; id += G) {
          int pr, pc; tile_map(id, nwg, nR, nC, pr, pc);
          EpiStore2 E{proj, INW, pr * 256, pr * 256 + 128};
          gemm_tile_staged(WV, smem, WIN, DM, pr * 256, pr * 256 + 128, xn, DM, pc * 256, DM, E);
        }
      } break;
      case 2: {
        mix_s5(WV, pp, l, proj, smem);
        mix_sb(WV, proj, smem);
        mix_dil(WV, proj, lse, pp->in[5], smem);
        mix_pool(WV, proj, pb);
      } break;
      case 3: {
        const int nR = 4, nC = TOK / 256, nwg = nR * nC;
        for (int id = BID; id < nwg; id += G) {
          int pr, pc; tile_map(id, nwg, nR, nC, pr, pc);
          EpiGated<1> E{proj, INW, O2 + 512 + pr * 128};
          gemm_tile_staged(WV, smem, WGLU, 512, pr * 128, 512 + pr * 128, proj + O3, INW, pc * 256, 512, E);
        }
        mix_dil_merge(WV, proj, lse);
      } break;
      case 4: {
        const int nR = 4, nC = TOK / 256, nwg = nR * nC;
        for (int id = BID; id < nwg; id += G) {
          int pr, pc; tile_map(id, nwg, nR, nC, pr, pc);
#pragma nounroll
          for (int b = 0; b < 4; ++b) {
            const int q = pr * 3 + b;
            u16* sd = (b == 3) ? mg + pr * 256 : proj + (q < 8 ? 768 + 256 * q : (q < 10 ? 256 * (q - 8) : 3840 + 256 * (q - 10)));
            EpiSig E1{sd, b == 3 ? DM : INW, pc * 256};
            gemm_tile(WV, smem, WG + (size_t)b * DM * DM, DM, pr * 256, pr * 256 + 128, xn, DM, pc * 256, DM, E1);
          }
          AccT acc = {};
#pragma nounroll
          for (int b = 0; b < 4; ++b) {
            const int Kb = (b == 1) ? 256 : 512, ldy = (b == 0) ? 512 : INW;
            const u16* yb = (b == 0) ? pb : proj + (b == 1 ? O1 : (b == 2 ? O2 : O2 + 512));
            const u16* wb = WB + DM * (b == 0 ? 0 : (b == 1 ? 512 : (b == 2 ? 768 : 1280)));
            gemm_core(WV, smem, wb, Kb, pr * 256, pr * 256 + 128, yb, ldy, pc * 256, Kb, acc);
            if (b < 3) {
              const int q = pr * 3 + b, q1 = q + 1;
              u16* sc = proj + (q < 8 ? 768 + 256 * q : (q < 10 ? 256 * (q - 8) : 3840 + 256 * (q - 10)));
              u16* sn = (b == 2) ? mg + pr * 256 : proj + (q1 < 8 ? 768 + 256 * q1 : (q1 < 10 ? 256 * (q1 - 8) : 3840 + 256 * (q1 - 10)));
              EpiRescale E2{sc, INW, sn, b == 2 ? DM : INW, pc * 256};
              apply_epi(WV, acc, pc * 256, E2);
            }
          }
          EpiFinalGate E3{mg, pr * 256, pc * 256};
          apply_epi_staged(WV, smem, acc, pc * 256, E3);
        }
      } break;
      case 5: {
        const int nR = 4, nC = TOK / 256, nwg = nR * nC;
        for (int id = BID; id < nwg; id += G) {
          int pr, pc; tile_map(id, nwg, nR, nC, pr, pc);
          AccT acc = {};
          gemm_core(WV, smem, WO, DM, pr * 256, pr * 256 + 128, mg, DM, pc * 256, DM, acc);
          resid_norm_epi(WV, smem, acc, pc * 256, xin, xres, pr * 256, pc, pr, (unsigned)(ph + 1), (u64*)(ws + WS_SLAB), pp->in[18] + (size_t)l * DM, xn, true);
        }
      } break;
      case 7: {
        const int nR = FFN / 128, nC = TOK / 256, nwg = nR * nC;
        for (int id = BID; id < nwg; id += G) {
          int pr, pc; tile_map(id, nwg, nR, nC, pr, pc);
          EpiGated<0> E{hbuf, FFN, pr * 128};
          gemm_tile_staged(WV, smem, WUP, DM, pr * 128, FFN + pr * 128, xn, DM, pc * 256, DM, E);
        }
      } break;
      case 8: {
        const int nR = 4, nC = TOK / 256, nwg = nR * nC;
        for (int id = BID; id < nwg; id += G) {
          int pr, pc; tile_map(id, nwg, nR, nC, pr, pc);
          AccT acc = {};
          gemm_core(WV, smem, WDN, FFN, pr * 256, pr * 256 + 128, hbuf, FFN, pc * 256, FFN, acc);
          resid_norm_epi(WV, smem, acc, pc * 256, xres, xres, pr * 256, pc, pr, (unsigned)(ph + 1), (u64*)(ws + WS_SLAB), pp->in[1] + (size_t)(l < DEPTH - 1 ? l + 1 : l) * DM, xn, l < DEPTH - 1);
        }
      } break;
    }
  }
}

extern "C" void kernel_launch(void* const* d_in, const int* in_sizes, int n_in, void* d_out, int out_size,
                              void* d_ws, size_t ws_size, hipStream_t stream) {
  static int grid = 0;
  if (grid == 0) {
    if (n_in != 22 || ws_size < WS_END) { fprintf(stderr, "kernel_launch: unexpected n_in %d / ws_size %zu (need %zu)\n", n_in, ws_size, (size_t)WS_END); grid = -1; return; }
    int dev = 0, cus = 0, per_cu = 0;
    hipGetDevice(&dev);
    hipDeviceGetAttribute(&cus, hipDeviceAttributeMultiprocessorCount, dev);
    if (hipFuncSetAttribute((const void*)mega, hipFuncAttributeMaxDynamicSharedMemorySize, LDS_BYTES) != hipSuccess) { fprintf(stderr, "hipFuncSetAttribute failed\n"); grid = -1; return; }
    if (hipOccupancyMaxActiveBlocksPerMultiprocessor(&per_cu, (const void*)mega, NTHR, LDS_BYTES) != hipSuccess || per_cu < 1) { fprintf(stderr, "occupancy query failed (%d)\n", per_cu); per_cu = 1; (void)hipGetLastError(); }
    grid = cus * per_cu;
  }
  if (grid < 0) return;
  if (hipMemsetAsync((char*)d_ws + WS_BAR, 0, WS_END - WS_BAR, stream) != hipSuccess) { fprintf(stderr, "memset of barrier words failed\n"); return; }
  Params p{};
  for (int i = 0; i < 22; ++i) p.in[i] = (const float*)d_in[i];
  p.out = (float*)d_out; p.ws = (char*)d_ws;
#if ONE_LAUNCH
  p.ph_lo = 0; p.ph_hi = N_PHASES;
  void* args[] = {&p};
  hipError_t e = hipLaunchCooperativeKernel((const void*)mega, dim3(grid), dim3(NTHR), args, LDS_BYTES, stream);
  if (e != hipSuccess) fprintf(stderr, "cooperative launch failed: %s (grid %d)\n", hipGetErrorString(e), grid);
#else
  for (int ph = 0; ph < N_PHASES; ++ph) {
    p.ph_lo = ph; p.ph_hi = ph + 1;
    hipLaunchKernelGGL(mega, dim3(grid), dim3(NTHR), LDS_BYTES, stream, p);
  }
#endif
}
```

```cpp
#include <hip/hip_runtime.h>
#include <hip/hip_bf16.h>
#include <hip/hip_cooperative_groups.h>
#include <cstdio>
namespace cg = cooperative_groups;

#ifndef ONE_LAUNCH
#define ONE_LAUNCH 1
#endif

typedef unsigned short u16;
using bf16x8 = __attribute__((ext_vector_type(8))) short;
using s16x4  = __attribute__((ext_vector_type(4))) short;
using f32x4  = __attribute__((ext_vector_type(4))) float;
using f32x16 = __attribute__((ext_vector_type(16))) float;
using u32x4  = __attribute__((ext_vector_type(4))) unsigned;
typedef __bf16 bf2_t __attribute__((ext_vector_type(2)));
typedef float f2_t __attribute__((ext_vector_type(2)));
#define DI __device__ __forceinline__
#define LAS __attribute__((address_space(3)))

constexpr int DM = 1024, BATCH = 8, SEQ = 4096, TOK = BATCH * SEQ, DEPTH = 4;
constexpr int INW = 4864, O1 = 512, O2 = 2816, O3 = 4352;
constexpr int FFN = 2816;
constexpr int NTHR = 512;
constexpr int LDS_BYTES = 147456;
constexpr int PH_PER_LAYER = 9, N_PHASES = DEPTH * PH_PER_LAYER;

constexpr size_t WS_PROJ = 0;
constexpr size_t WS_XN   = WS_PROJ + (size_t)TOK * INW * 2;
constexpr size_t WS_PB   = WS_XN + (size_t)TOK * DM * 2;
constexpr size_t WS_MG   = WS_PB + (size_t)TOK * 512 * 2;
constexpr size_t WS_LSE  = WS_MG + (size_t)TOK * DM * 2;
constexpr size_t WS_WIN  = WS_LSE + (size_t)TOK * 12 * 4;
constexpr size_t WS_WG   = WS_WIN + (size_t)INW * DM * 2;
constexpr size_t WS_WB   = WS_WG + (size_t)4 * DM * DM * 2;
constexpr size_t WS_WO   = WS_WB + (size_t)DM * 1792 * 2;
constexpr size_t WS_WUP  = WS_WO + (size_t)DM * DM * 2;
constexpr size_t WS_WDN  = WS_WUP + (size_t)2 * FFN * DM * 2;
constexpr size_t WS_WGLU = WS_WDN + (size_t)DM * FFN * 2;
constexpr size_t WS_BAR  = WS_WGLU + (size_t)DM * 512 * 2;
constexpr size_t WS_SLAB = WS_BAR + 16384;
constexpr size_t WS_END  = WS_SLAB + (size_t)128 * 4 * 256 * 8;

struct Params {
  const float* in[22];
  float* out;
  char* ws;
  int ph_lo, ph_hi;
};
typedef const Params __attribute__((address_space(4)))* CP;

DI unsigned pack2(float a, float b) { f2_t v = {a, b}; bf2_t r = __builtin_convertvector(v, bf2_t); return __builtin_bit_cast(unsigned, r); }
DI u16 f2bf(float a) { return (u16)(pack2(a, 0.f) & 0xffffu); }
DI float bf2f(u16 v) { return __uint_as_float(((unsigned)v) << 16); }
DI float bflo(unsigned v) { return __uint_as_float(v << 16); }
DI float bfhi(unsigned v) { return __uint_as_float(v & 0xffff0000u); }
DI void store4bf(u16* p, f32x4 a) { uint2 v; v.x = pack2(a[0], a[1]); v.y = pack2(a[2], a[3]); *(uint2*)p = v; }
DI f32x4 load4bf(const u16* p) { uint2 v = *(const uint2*)p; f32x4 r = {bflo(v.x), bfhi(v.x), bflo(v.y), bfhi(v.y)}; return r; }
DI float fexp2(float x) { return __builtin_amdgcn_exp2f(x); }
DI float flog2(float x) { return __builtin_amdgcn_logf(x); }
DI float frcp(float x) { return __builtin_amdgcn_rcpf(x); }
DI float sigmoidf_(float x) { return frcp(1.f + fexp2(-1.44269504089f * x)); }
DI float siluf_(float x) { return x * sigmoidf_(x); }
DI float gelu_tanh(float x) {
  float u = 0.7978845608028654f * (x + 0.044715f * x * x * x);
  float e = fexp2(2.885390081777927f * u);
  float th = 1.f - 2.f * frcp(1.f + e);
  return 0.5f * x * (1.f + th);
}
DI int get_tid(int wv) { int l; asm volatile("v_mbcnt_lo_u32_b32 %0, -1, 0\n\tv_mbcnt_hi_u32_b32 %0, -1, %0" : "=v"(l)); return wv * 64 + l; }
DI int get_bid() { int b = blockIdx.x; asm volatile("" : "+s"(b)); return b; }
DI int get_grid() { int g = gridDim.x; asm volatile("" : "+s"(g)); return g; }
DI int wave_of(int tid) { return __builtin_amdgcn_readfirstlane(tid >> 6); }
#define WVP const int WV,
DI float shflx(float v, int mask, int lane) { return __int_as_float(__builtin_amdgcn_ds_bpermute((lane ^ mask) << 2, __float_as_int(v))); }
DI int crow(int i, int h) { return (i & 3) + 8 * (i >> 2) + 4 * h; }
#define MFMA32(a, b, c) __builtin_amdgcn_mfma_f32_32x32x16_bf16((a), (b), (c), 0, 0, 0)
#define MFMA16(a, b, c) __builtin_amdgcn_mfma_f32_16x16x32_bf16((a), (b), (c), 0, 0, 0)
DI s16x4 tr_read(const char* p) { return __builtin_amdgcn_ds_read_tr16_b64_v4i16((LAS s16x4*)p); }
DI bf16x8 packP(const f32x16& x, int s) {
  unsigned a = pack2(x[8 * s], x[8 * s + 1]), b = pack2(x[8 * s + 2], x[8 * s + 3]);
  unsigned c = pack2(x[8 * s + 4], x[8 * s + 5]), d = pack2(x[8 * s + 6], x[8 * s + 7]);
  uint4 v = {a, b, c, d};
  return __builtin_bit_cast(bf16x8, v);
}

constexpr int BK = 64, HALF = 128, HT = HALF * BK;
DI int lds_byte(int r, int c) {
  int st = (r >> 4) * 2 + (c >> 5), rr = r & 15, cc = c & 31, ob = rr * 64 + cc * 2;
  return st * 1024 + (ob ^ (((ob >> 9) & 1) << 5));
}
DI void stage_rc(int b, int& R, int& C) {
  int st = b / 1024, sb = b % 1024, swz = sb ^ (((sb >> 9) & 1) << 5);
  R = (st >> 1) * 16 + swz / 64; C = (st & 1) * 32 + (swz % 64) / 2;
}

typedef f32x4 AccT[2][2][4][2];
DI void gemm_core(WVP char* smem, const u16* __restrict__ A, int lda, int ar0, int ar1,
                  const u16* __restrict__ B, int ldb, int bc0, int K, AccT& acc) {
  u16* shm = (u16*)smem;
#define SA(b, h) (shm + ((b) * 2 + (h)) * HT)
#define SB(b, h) (shm + (4 + (b) * 2 + (h)) * HT)
#define STAGE_A(P, br, kt) do { const char* _g = (const char*)(A + (long)(br) * lda + (long)(kt) * BK); \
    __builtin_amdgcn_global_load_lds((const unsigned*)(_g + (size_t)offA0), (unsigned*)((char*)(P) + sb0), 16, 0, 0); \
    __builtin_amdgcn_global_load_lds((const unsigned*)(_g + (size_t)lda * 128 + (size_t)offA0), (unsigned*)((char*)(P) + sb1), 16, 0, 0); } while (0)
#define STAGE_B(P, br, kt) do { const char* _g = (const char*)(B + (long)(br) * ldb + (long)(kt) * BK); \
    __builtin_amdgcn_global_load_lds((const unsigned*)(_g + (size_t)offB0), (unsigned*)((char*)(P) + sb0), 16, 0, 0); \
    __builtin_amdgcn_global_load_lds((const unsigned*)(_g + (size_t)ldb * 128 + (size_t)offB0), (unsigned*)((char*)(P) + sb1), 16, 0, 0); } while (0)
#define LDA(dst, b, h) for (int m = 0; m < 4; ++m) for (int k = 0; k < 2; ++k) \
    dst[m][k] = *reinterpret_cast<const bf16x8*>((char*)SA(b, h) + lds_byte(wr * 64 + m * 16 + fr, k * 32 + fq * 8))
#define LDB(dst, b, h) for (int n = 0; n < 2; ++n) for (int k = 0; k < 2; ++k) \
    dst[n][k] = *reinterpret_cast<const bf16x8*>((char*)SB(b, h) + lds_byte(wc * 32 + n * 16 + fr, k * 32 + fq * 8))
#define MMA(ai, bj, At_, Bt_) do { __builtin_amdgcn_s_setprio(1); \
    for (int m = 0; m < 4; ++m) for (int n = 0; n < 2; ++n) for (int k = 0; k < 2; ++k) \
      acc[ai][bj][m][n] = MFMA16(At_[m][k], Bt_[n][k], acc[ai][bj][m][n]); \
    __builtin_amdgcn_s_setprio(0); } while (0)
#define WAIT_V(n) asm volatile("s_waitcnt vmcnt(" #n ")" ::: "memory")
#define WAIT_L(n) asm volatile("s_waitcnt lgkmcnt(" #n ")" ::: "memory")
#define BAR __builtin_amdgcn_s_barrier()
#define SCHED __builtin_amdgcn_sched_barrier(0)

  const int tid = get_tid(WV);
  const int wid = wave_of(tid), lane = tid & 63, wr = wid >> 2, wc = wid & 3, fr = lane & 15, fq = lane >> 4;
  const int sb0 = tid * 16, sb1 = sb0 + 8192;
  int R0, C0; stage_rc(sb0, R0, C0);
  const unsigned offA0 = (unsigned)(R0 * lda + C0) * 2u, offB0 = (unsigned)(R0 * ldb + C0) * 2u;
  const int ac0 = ar0, ac1 = ar1, bb0 = bc0, bb1 = bc0 + HALF;
  bf16x8 At[4][2], B0[2][2], B1[2][2];
  const int nt = K / BK;
  __syncthreads();
  STAGE_B(SB(0, 0), bb0, 0); STAGE_A(SA(0, 0), ac0, 0);
  STAGE_B(SB(0, 1), bb1, 0); STAGE_A(SA(0, 1), ac1, 0);
  if (wr == 1) BAR;
  WAIT_V(4); BAR;
  STAGE_B(SB(1, 0), bb0, 1); STAGE_A(SA(1, 0), ac0, 1); STAGE_B(SB(1, 1), bb1, 1);
  WAIT_V(6); BAR;
  for (int t = 0; t < nt - 2; t += 2) {
    LDB(B0, 0, 0); SCHED; LDA(At, 0, 0); STAGE_A(SA(1, 1), ac1, t + 1);
    WAIT_L(8); BAR; WAIT_L(0); MMA(0, 0, At, B0); BAR; SCHED;
    LDB(B1, 0, 1); STAGE_B(SB(0, 0), bb0, t + 2);
    BAR; WAIT_L(0); MMA(0, 1, At, B1); BAR;
    LDA(At, 0, 1); STAGE_A(SA(0, 0), ac0, t + 2);
    BAR; WAIT_L(0); MMA(1, 0, At, B0); BAR; SCHED;
    STAGE_B(SB(0, 1), bb1, t + 2);
    WAIT_V(6); BAR; MMA(1, 1, At, B1); BAR;
    LDB(B0, 1, 0); SCHED; LDA(At, 1, 0); STAGE_A(SA(0, 1), ac1, t + 2);
    WAIT_L(8); BAR; WAIT_L(0); MMA(0, 0, At, B0); BAR; SCHED;
    LDB(B1, 1, 1); STAGE_B(SB(1, 0), bb0, t + 3);
    BAR; WAIT_L(0); MMA(0, 1, At, B1); BAR;
    LDA(At, 1, 1); STAGE_A(SA(1, 0), ac0, t + 3);
    BAR; WAIT_L(0); MMA(1, 0, At, B0); BAR; SCHED;
    STAGE_B(SB(1, 1), bb1, t + 3);
    WAIT_V(6); BAR; MMA(1, 1, At, B1); BAR;
  }
  { LDB(B0, 0, 0); LDA(At, 0, 0); STAGE_A(SA(1, 1), ac1, nt - 1);
    BAR; WAIT_L(0); MMA(0, 0, At, B0); BAR;
    LDB(B1, 0, 1); BAR; WAIT_L(0); MMA(0, 1, At, B1); BAR;
    LDA(At, 0, 1); WAIT_V(4); BAR; WAIT_L(0); MMA(1, 0, At, B0); MMA(1, 1, At, B1); BAR; }
  { LDB(B0, 1, 0); LDA(At, 1, 0); WAIT_V(2); BAR; WAIT_L(0); MMA(0, 0, At, B0); BAR;
    LDB(B1, 1, 1); WAIT_V(0); BAR; WAIT_L(0); MMA(0, 1, At, B1); BAR;
    LDA(At, 1, 1); BAR; WAIT_L(0); MMA(1, 0, At, B0); MMA(1, 1, At, B1); BAR; }
  if (wr == 0) BAR;
#undef SA
#undef SB
}
template <class Epi>
DI void apply_epi(WVP AccT& acc, int bc0, const Epi& epi) {
  const int t2 = get_tid(WV);
  const int wid2 = wave_of(t2), lane2 = t2 & 63, wr2 = wid2 >> 2, wc2 = wid2 & 3, fr2 = lane2 & 15, fq2 = lane2 >> 4;
  for (int bj = 0; bj < 2; ++bj) for (int m = 0; m < 4; ++m) {
    for (int n = 0; n < 2; ++n)
      epi(acc[0][bj][m][n], acc[1][bj][m][n], wr2 * 64 + m * 16 + fq2 * 4, bc0 + bj * HALF + wc2 * 32 + n * 16 + fr2, bj * 8 + m * 2 + n, t2);
    if (m & 1) __builtin_amdgcn_sched_barrier(0);
  }
}
template <class Epi>
DI void apply_epi_staged(WVP char* smem, AccT& acc, int bc0, const Epi& epi) {
  constexpr int NC = Epi::NC, PITCH = NC * 2 + 16;
  const int t2 = get_tid(WV);
  const int wid2 = wave_of(t2), lane2 = t2 & 63, wr2 = wid2 >> 2, wc2 = wid2 & 3, fr2 = lane2 & 15, fq2 = lane2 >> 4;
  for (int bj = 0; bj < 2; ++bj) for (int m = 0; m < 4; ++m) {
    for (int n = 0; n < 2; ++n) {
      const int rl = wr2 * 64 + m * 16 + fq2 * 4, tc = bj * HALF + wc2 * 32 + n * 16 + fr2;
      f32x4 r0, r1;
      epi.tr(acc[0][bj][m][n], acc[1][bj][m][n], rl, bc0 + tc, bj * 8 + m * 2 + n, t2, r0, r1);
      uint2 v0; v0.x = pack2(r0[0], r0[1]); v0.y = pack2(r0[2], r0[3]);
      *(uint2*)(smem + tc * PITCH + rl * 2) = v0;
      if (NC == 256) { uint2 v1; v1.x = pack2(r1[0], r1[1]); v1.y = pack2(r1[2], r1[3]); *(uint2*)(smem + tc * PITCH + (HALF + rl) * 2) = v1; }
    }
    if (m & 1) __builtin_amdgcn_sched_barrier(0);
  }
  __syncthreads();
  constexpr int CPR = NC / 8;
#pragma unroll
  for (int i = 0; i < 256 * CPR / NTHR; ++i) {
    const int L = i * NTHR + t2, row = L / CPR, ch = L % CPR;
    const u32x4 v = *(const u32x4*)(smem + row * PITCH + ch * 16);
    *(u32x4*)(epi.out(bc0 + row, ch)) = v;
  }
}
template <class Epi>
DI void gemm_tile(WVP char* smem, const u16* __restrict__ A, int lda, int ar0, int ar1,
                  const u16* __restrict__ B, int ldb, int bc0, int K, const Epi& epi) {
  AccT acc = {};
  gemm_core(WV, smem, A, lda, ar0, ar1, B, ldb, bc0, K, acc);
  apply_epi(WV, acc, bc0, epi);
}
template <class Epi>
DI void gemm_tile_staged(WVP char* smem, const u16* __restrict__ A, int lda, int ar0, int ar1,
                  const u16* __restrict__ B, int ldb, int bc0, int K, const Epi& epi) {
  AccT acc = {};
  gemm_core(WV, smem, A, lda, ar0, ar1, B, ldb, bc0, K, acc);
  apply_epi_staged(WV, smem, acc, bc0, epi);
}

DI void tile_map(int id, int nwg, int nR, int nC, int& pr, int& pc) {
  constexpr int NX = 8, WGM = 4;
  int q = nwg / NX, r = nwg % NX, xcd = id % NX, off = id / NX;
  id = (xcd < r ? xcd * (q + 1) : r * (q + 1) + (xcd - r) * q) + off;
  int nig = WGM * nC, gid = id / nig, fm = gid * WGM, gsz = min(nR - fm, WGM);
  pr = fm + ((id % nig) % gsz); pc = (id % nig) / gsz;
}

struct EpiStore2 { static constexpr int NC = 256; u16* dst; int ld; int n0, n1;
  DI void tr(const f32x4& a0, const f32x4& a1, int, int, int, int, f32x4& r0, f32x4& r1) const { r0 = a0; r1 = a1; }
  DI u16* out(int row, int ch) const { return dst + (long)row * ld + (ch < 16 ? n0 + ch * 8 : n1 + (ch - 16) * 8); } };
template <int ACT> struct EpiGated { static constexpr int NC = 128; u16* dst; int ld; int nb;
  DI void tr(const f32x4& a0, const f32x4& a1, int, int, int, int, f32x4& r0, f32x4& r1) const {
    for (int j = 0; j < 4; ++j) r0[j] = ACT == 0 ? siluf_(a0[j]) * a1[j] : a0[j] * sigmoidf_(a1[j]);
    r1 = r0; }
  DI u16* out(int row, int ch) const { return dst + (long)row * ld + nb + ch * 8; } };
struct EpiResid { const float* xin; float* xout; int n0, n1;
  DI void operator()(f32x4& a0, f32x4& a1, int rl, int col, int, int) const {
    f32x4 v0 = *(const f32x4*)(xin + (long)col * DM + n0 + rl), v1 = *(const f32x4*)(xin + (long)col * DM + n1 + rl);
    *(f32x4*)(xout + (long)col * DM + n0 + rl) = v0 + a0; *(f32x4*)(xout + (long)col * DM + n1 + rl) = v1 + a1; } };
DI u16* stash_ptr(u16* base, int ld, int bc0, int j, int tid) { const int L = j * NTHR + tid; return base + (long)(bc0 + (L >> 5)) * ld + (L & 31) * 8; }
DI void unpack8(const u32x4& v, f32x4& lo, f32x4& hi) { lo = f32x4{bflo(v[0]), bfhi(v[0]), bflo(v[1]), bfhi(v[1])}; hi = f32x4{bflo(v[2]), bfhi(v[2]), bflo(v[3]), bfhi(v[3])}; }
struct EpiSig { u16* dst; int ld; int bc0;
  DI void operator()(f32x4& a0, f32x4& a1, int, int, int j, int tid) const {
    f32x4 r0, r1;
    for (int q = 0; q < 4; ++q) { r0[q] = fmaxf(sigmoidf_(a0[q]), 1e-20f); r1[q] = fmaxf(sigmoidf_(a1[q]), 1e-20f); }
    u32x4 v = {pack2(r0[0], r0[1]), pack2(r0[2], r0[3]), pack2(r1[0], r1[1]), pack2(r1[2], r1[3])};
    *(u32x4*)stash_ptr(dst, ld, bc0, j, tid) = v; } };
struct EpiRescale { u16* sc; int ldc; u16* sn; int ldn; int bc0;
  DI void operator()(f32x4& a0, f32x4& a1, int, int, int j, int tid) const {
    const u32x4 vc = *(const u32x4*)stash_ptr(sc, ldc, bc0, j, tid), vn = *(const u32x4*)stash_ptr(sn, ldn, bc0, j, tid);
    f32x4 c0, c1, n0, n1; unpack8(vc, c0, c1); unpack8(vn, n0, n1);
    for (int q = 0; q < 4; ++q) { a0[q] *= c0[q] * frcp(n0[q]); a1[q] *= c1[q] * frcp(n1[q]); } } };
struct EpiFinalGate { static constexpr int NC = 256; u16* mg; int nbase; int bc0;
  DI void tr(const f32x4& a0, const f32x4& a1, int, int, int j, int tid, f32x4& r0, f32x4& r1) const {
    const u32x4 vc = *(const u32x4*)stash_ptr(mg + nbase, DM, bc0, j, tid);
    f32x4 c0, c1; unpack8(vc, c0, c1); r0 = a0 * c0; r1 = a1 * c1; }
  DI u16* out(int row, int ch) const { return mg + (long)row * DM + nbase + ch * 8; } };

typedef unsigned long long u64;
typedef __attribute__((address_space(1))) u64 gu64;
struct EpiNormOut { static constexpr int NC = 256; u16* xn; int n0; const float* g; const float* rsb; int bc0;
  DI void tr(const f32x4& a0, const f32x4& a1, int rl, int col, int, int, f32x4& r0, f32x4& r1) const {
    const float rs = rsb[col - bc0];
    const f32x4 g0 = *(const f32x4*)(g + n0 + rl), g1 = *(const f32x4*)(g + n0 + HALF + rl);
    r0 = a0 * g0 * rs; r1 = a1 * g1 * rs; }
  DI u16* out(int row, int ch) const { return xn + (long)row * DM + n0 + ch * 8; } };
DI void resid_norm_epi(WVP char* smem, AccT& acc, int bc0, const float* xin, float* xout, int n0, int pc, int pr, unsigned epoch,
                       u64* slab, const float* g, u16* xn, int mode) {
  const int t2 = get_tid(WV);
  const int wid2 = wave_of(t2), lane2 = t2 & 63, wr2 = wid2 >> 2, wc2 = wid2 & 3, fr2 = lane2 & 15, fq2 = lane2 >> 4;
  float* part = (float*)(smem + 139264);
  float* rsb = part + 512;
  float sq[2][2] = {{0.f, 0.f}, {0.f, 0.f}};
  for (int bj = 0; bj < 2; ++bj) for (int m = 0; m < 4; ++m) {
    for (int n = 0; n < 2; ++n) {
      const int rl = wr2 * 64 + m * 16 + fq2 * 4, col = bc0 + bj * HALF + wc2 * 32 + n * 16 + fr2;
      const f32x4 v0 = *(const f32x4*)(xin + (long)col * DM + n0 + rl) + acc[0][bj][m][n], v1 = *(const f32x4*)(xin + (long)col * DM + n0 + HALF + rl) + acc[1][bj][m][n];
      if (mode != 2) { *(f32x4*)(xout + (long)col * DM + n0 + rl) = v0; *(f32x4*)(xout + (long)col * DM + n0 + HALF + rl) = v1; }
      acc[0][bj][m][n] = v0; acc[1][bj][m][n] = v1;
      sq[bj][n] += v0[0] * v0[0] + v0[1] * v0[1] + v0[2] * v0[2] + v0[3] * v0[3] + v1[0] * v1[0] + v1[1] * v1[1] + v1[2] * v1[2] + v1[3] * v1[3];
    }
    if (m & 1) __builtin_amdgcn_sched_barrier(0);
  }
  for (int bj = 0; bj < 2; ++bj) for (int n = 0; n < 2; ++n) {
    float sv = sq[bj][n]; sv += shflx(sv, 16, lane2); sv += shflx(sv, 32, lane2);
    if (fq2 == 0) part[wr2 * 256 + bj * HALF + wc2 * 32 + n * 16 + fr2] = sv;
  }
  __syncthreads();
  if (t2 < 256) {
    const float tot = part[t2] + part[256 + t2];
    __hip_atomic_store((gu64*)(slab + ((size_t)(pc * 4 + pr) * 256 + t2)), ((u64)epoch << 32) | (u64)__float_as_uint(tot), __ATOMIC_RELAXED, __HIP_MEMORY_SCOPE_AGENT);
    gu64* gb = (gu64*)(slab + ((size_t)(pc * 4) * 256 + t2));
    float sum = 0.f;
    for (unsigned spins = 0;; ++spins) {
      bool ok = true; sum = 0.f;
#pragma unroll
      for (int q = 0; q < 4; ++q) { const u64 x = __hip_atomic_load(gb + q * 256, __ATOMIC_RELAXED, __HIP_MEMORY_SCOPE_AGENT); ok &= (unsigned)(x >> 32) == epoch; sum += __uint_as_float((unsigned)x); }
      if (__all(ok) || spins > (1u << 22)) break;
      __builtin_amdgcn_s_sleep(1);
    }
    rsb[t2] = rsqrtf(sum * (1.f / DM) + 1e-6f);
  }
  __syncthreads();
  if (mode == 1) { EpiNormOut E{xn, n0, g, rsb, bc0}; apply_epi_staged(WV, smem, acc, bc0, E); }
  if (mode == 2) {
    for (int bj = 0; bj < 2; ++bj) for (int m = 0; m < 4; ++m) {
      for (int n = 0; n < 2; ++n) {
        const int rl = wr2 * 64 + m * 16 + fq2 * 4, tc = bj * HALF + wc2 * 32 + n * 16 + fr2;
        const float rs = rsb[tc];
        const f32x4 g0 = *(const f32x4*)(g + n0 + rl), g1 = *(const f32x4*)(g + n0 + HALF + rl);
        *(f32x4*)(xout + (long)(bc0 + tc) * DM + n0 + rl) = acc[0][bj][m][n] * g0 * rs;
        *(f32x4*)(xout + (long)(bc0 + tc) * DM + n0 + HALF + rl) = acc[1][bj][m][n] * g1 * rs;
      }
      if (m & 1) __builtin_amdgcn_sched_barrier(0);
    }
  }
}

DI void phase_rmsnorm(WVP const float* __restrict__ x, const float* __restrict__ g, u16* __restrict__ o) {
  const int BID = get_bid(), GRD = get_grid();
  const int tid = get_tid(WV), wave = wave_of(tid), lane = tid & 63;
  f32x4 gv[4];
  for (int i = 0; i < 4; ++i) gv[i] = *(const f32x4*)(g + i * 256 + lane * 4);
  for (int row = BID * 8 + wave; row < TOK; row += GRD * 8) {
    f32x4 v[4]; float ss = 0.f;
    for (int i = 0; i < 4; ++i) { v[i] = *(const f32x4*)(x + (long)row * DM + i * 256 + lane * 4); ss += v[i][0] * v[i][0] + v[i][1] * v[i][1] + v[i][2] * v[i][2] + v[i][3] * v[i][3]; }
    for (int d = 32; d >= 1; d >>= 1) ss += shflx(ss, d, lane);
    float rs = rsqrtf(ss * (1.f / DM) + 1e-6f);
    for (int i = 0; i < 4; ++i) store4bf(o + (long)row * DM + i * 256 + lane * 4, v[i] * rs * gv[i]);
  }
}
DI void phase_final_norm(WVP float* __restrict__ x, const float* __restrict__ g) {
  const int BID = get_bid(), GRD = get_grid();
  const int tid = get_tid(WV), wave = wave_of(tid), lane = tid & 63;
  f32x4 gv[4];
  for (int i = 0; i < 4; ++i) gv[i] = *(const f32x4*)(g + i * 256 + lane * 4);
  for (int row = BID * 8 + wave; row < TOK; row += GRD * 8) {
    f32x4 v[4]; float ss = 0.f;
    for (int i = 0; i < 4; ++i) { v[i] = *(const f32x4*)(x + (long)row * DM + i * 256 + lane * 4); ss += v[i][0] * v[i][0] + v[i][1] * v[i][1] + v[i][2] * v[i][2] + v[i][3] * v[i][3]; }
    for (int d = 32; d >= 1; d >>= 1) ss += shflx(ss, d, lane);
    float rs = rsqrtf(ss * (1.f / DM) + 1e-6f);
    for (int i = 0; i < 4; ++i) *(f32x4*)(x + (long)row * DM + i * 256 + lane * 4) = v[i] * rs * gv[i];
  }
}

DI void transpose_tile(WVP float* sm, const float* __restrict__ src, int lds_, u16* __restrict__ dst, int ldd, int k0, int n0) {
  const int tid = get_tid(WV);
  constexpr int P = 257;
  f32x4 v[8];
  const int rb = tid >> 6, c4 = (tid & 63) * 4;
#pragma unroll
  for (int i = 0; i < 8; ++i) v[i] = *(const f32x4*)(src + (long)(k0 + rb + 8 * i) * lds_ + n0 + c4);
  __syncthreads();
#pragma unroll
  for (int i = 0; i < 8; ++i) for (int j = 0; j < 4; ++j) sm[(rb + 8 * i) * P + c4 + j] = v[i][j];
  __syncthreads();
#pragma unroll
  for (int i = 0; i < 4; ++i) {
    const int c = tid + NTHR * i, n = c >> 3, k8 = (c & 7) * 8;
    u32x4 o;
    o[0] = pack2(sm[(k8 + 0) * P + n], sm[(k8 + 1) * P + n]); o[1] = pack2(sm[(k8 + 2) * P + n], sm[(k8 + 3) * P + n]);
    o[2] = pack2(sm[(k8 + 4) * P + n], sm[(k8 + 5) * P + n]); o[3] = pack2(sm[(k8 + 6) * P + n], sm[(k8 + 7) * P + n]);
    *(u32x4*)(dst + (long)(n0 + n) * ldd + k0 + k8) = o;
  }
}
DI void phase_wprep(WVP CP pp, int l, char* smem) {
  const int BID = get_bid(), GRD = get_grid();
  char* ws = pp->ws;
  float* sm = (float*)smem;
  const float* w_in = pp->in[2] + (size_t)l * DM * INW;
  const float* w_gate = pp->in[16] + (size_t)l * 4 * DM * DM;
  const float* w_branch = pp->in[15] + (size_t)l * 1792 * DM;
  const float* w_out = pp->in[17] + (size_t)l * DM * DM;
  const float* w_up = pp->in[19] + (size_t)l * DM * 2 * FFN;
  const float* w_down = pp->in[20] + (size_t)l * FFN * DM;
  const float* w_glu = pp->in[14] + (size_t)l * 512 * 1024;
  u16* WB = (u16*)(ws + WS_WB);
  constexpr int NJ = 12;
  const float* src[NJ] = {w_in, w_gate, w_gate + DM * DM, w_gate + 2 * DM * DM, w_gate + 3 * DM * DM,
                          w_branch + 512 * DM, w_branch + 768 * DM, w_branch + 1280 * DM, w_out, w_up, w_down, w_glu};
  const int lds_[NJ] = {INW, DM, DM, DM, DM, DM, DM, DM, DM, 2 * FFN, DM, 1024};
  const int Kd[NJ] = {DM, DM, DM, DM, DM, 256, 512, 512, DM, DM, FFN, 512};
  const int Nd[NJ] = {INW, DM, DM, DM, DM, DM, DM, DM, DM, 2 * FFN, DM, 1024};
  u16* dst[NJ] = {(u16*)(ws + WS_WIN), (u16*)(ws + WS_WG), (u16*)(ws + WS_WG) + DM * DM, (u16*)(ws + WS_WG) + 2 * DM * DM, (u16*)(ws + WS_WG) + 3 * DM * DM,
                  WB + DM * 512, WB + DM * 768, WB + DM * 1280, (u16*)(ws + WS_WO), (u16*)(ws + WS_WUP), (u16*)(ws + WS_WDN), (u16*)(ws + WS_WGLU)};
  int base = 0;
#pragma unroll
  for (int j = 0; j < NJ; ++j) {
    int nk = Kd[j] / 64, nn = Nd[j] / 256, cnt = nk * nn;
    int first = (BID - base % GRD + GRD) % GRD;
    for (int i = first; i < cnt; i += GRD) transpose_tile(WV, sm, src[j], lds_[j], dst[j], Kd[j], (i / nn) * 64, (i % nn) * 256);
    base += cnt;
  }
  const float* pool_w = pp->in[3] + (size_t)l * 4 * 128 * 128;
  const float* pool_s = pp->in[4] + (size_t)l * 512;
  for (int it = GRD - 1 - BID; it < 16 * 16; it += GRD) {
    const int k0 = (it >> 4) * 32, n0 = (it & 15) * 64;
    const int tid = get_tid(WV);
    const int n = n0 + (tid & 63), kb = k0 + (tid >> 6) * 4, g = kb >> 7;
    float accv[4] = {0, 0, 0, 0};
    const float* pw = pool_w + (size_t)(g * 128 + (kb & 127)) * 128;
#pragma unroll 2
    for (int d = 0; d < 128; d += 4) {
      const f32x4 ps = *(const f32x4*)(pool_s + g * 128 + d);
      float wv[4];
      for (int q = 0; q < 4; ++q) wv[q] = ps[q] * w_branch[(long)(g * 128 + d + q) * DM + n];
      for (int jj = 0; jj < 4; ++jj) {
        const f32x4 p4 = *(const f32x4*)(pw + jj * 128 + d);
        accv[jj] += p4[0] * wv[0] + p4[1] * wv[1] + p4[2] * wv[2] + p4[3] * wv[3];
      }
    }
    uint2 o; o.x = pack2(accv[0], accv[1]); o.y = pack2(accv[2], accv[3]);
    *(uint2*)(WB + (long)n * 512 + kb) = o;
  }
}

DI void mix_pool(WVP const u16* __restrict__ proj, u16* __restrict__ pb) {
  const int BID = get_bid(), GRD = get_grid();
  const int tid = get_tid(WV);
  for (int idx = BID * NTHR + tid; idx < (TOK / 16) * 64; idx += GRD * NTHR) {
    const int cc = idx & 63, t0 = (idx >> 6) * 16, gi = cc >> 4, w = 2 << gi, s0 = t0 & (SEQ - 1);
    const u16* base = proj + (long)t0 * INW + cc * 8;
    float a[8] = {0, 0, 0, 0, 0, 0, 0, 0};
    for (int i = 1; i < w; ++i) {
      if (s0 - i >= 0) {
        const u32x4 v = *(const u32x4*)(base - (long)i * INW);
        a[0] += bflo(v[0]); a[1] += bfhi(v[0]); a[2] += bflo(v[1]); a[3] += bfhi(v[1]); a[4] += bflo(v[2]); a[5] += bfhi(v[2]); a[6] += bflo(v[3]); a[7] += bfhi(v[3]);
      }
    }
#pragma unroll 4
    for (int k = 0; k < 16; ++k) {
      const int s = s0 + k;
      const u32x4 v = *(const u32x4*)(base + (long)k * INW);
      float u[8] = {bflo(v[0]), bfhi(v[0]), bflo(v[1]), bfhi(v[1]), bflo(v[2]), bfhi(v[2]), bflo(v[3]), bfhi(v[3])};
      for (int q = 0; q < 8; ++q) a[q] += u[q];
      const float ic = 1.f / (float)min(w, s + 1);
      u32x4 o;
      o[0] = pack2(a[0] * ic - u[0], a[1] * ic - u[1]); o[1] = pack2(a[2] * ic - u[2], a[3] * ic - u[3]);
      o[2] = pack2(a[4] * ic - u[4], a[5] * ic - u[5]); o[3] = pack2(a[6] * ic - u[6], a[7] * ic - u[7]);
      *(u32x4*)(pb + (long)(t0 + k) * 512 + cc * 8) = o;
      if (s - w + 1 >= 0) {
        const u32x4 x = *(const u32x4*)(base + (long)(k - w + 1) * INW);
        a[0] -= bflo(x[0]); a[1] -= bfhi(x[0]); a[2] -= bflo(x[1]); a[3] -= bfhi(x[1]); a[4] -= bflo(x[2]); a[5] -= bfhi(x[2]); a[6] -= bflo(x[3]); a[7] -= bfhi(x[3]);
      }
    }
  }
}

DI int t5_bucket(int dist) {
  if (dist < 16) return dist;
  const int thr[15] = {22, 30, 40, 54, 73, 99, 134, 182, 246, 332, 450, 609, 825, 1117, 1513};
  int b = 16;
#pragma unroll
  for (int k = 0; k < 15; ++k) b += (dist >= thr[k]) ? 1 : 0;
  return b;
}
DI void mix_dil(WVP u16* __restrict__ proj, float* __restrict__ lse, const float* __restrict__ rel_bias, char* smem) {
  const int BID = get_bid(), GRD = get_grid();
  const int tid = get_tid(WV), wave = wave_of(tid), lane = tid & 63, h = lane >> 5, l31 = lane & 31;
  float* btab = (float*)smem;
  char* vbuf = smem + 12 * 132 * 4 + wave * 4608;
  __syncthreads();
  for (int i = tid; i < 12 * 129; i += NTHR) {
    int H = i / 129, ds = i % 129, g = H >> 2; int dil = g == 0 ? 1 : (g == 1 ? 4 : 16);
    btab[H * 132 + ds] = rel_bias[t5_bucket(ds * dil) * 12 + H] * 1.44269504089f;
  }
  __syncthreads();
  const float sc = 1.44269504089f * 0.125f;
  const int i16 = lane & 15, tq = i16 >> 2, tp = i16 & 3, blk = (lane >> 4) & 1;
#define DIL_DECODE(u_, tb_, q0_, H_, dil_, j0_) \
    const int v_ = (u_) & 127, hh_ = ((u_) >> 7) & 3, g_ = ((u_) >> 9) % 3, b_ = (u_) / (512 * 3); \
    const int dsh_ = g_ * 2; dil_ = 1 << dsh_; const int nq_ = (SEQ >> dsh_) >> 5; \
    const int r_ = v_ / nq_; q0_ = (v_ % nq_) * 32; H_ = g_ * 4 + hh_; tb_ = (long)b_ * SEQ + r_; j0_ = q0_ >= 128 ? 0 : (128 - q0_) >> 5;
  bf16x8 bq_n[4], ak_n[4]; u32x4 vv_n[4];
  const int u_first = BID * 8 + wave, u_step = GRD * 8, u_end = BATCH * 3 * 4 * 128;
  if (u_first < u_end) {
    long tb; int q0, H, dil, j0; DIL_DECODE(u_first, tb, q0, H, dil, j0)
    const u16* qp = proj + (tb + (long)(q0 + l31) * dil) * INW + O1 + H * 64;
    for (int s = 0; s < 4; ++s) bq_n[s] = *(const bf16x8*)(qp + 16 * s + 8 * h);
    const u16* kp = proj + (tb + (long)(q0 - 128 + 32 * j0 + l31) * dil) * INW + O1 + 768 + H * 64;
    for (int s = 0; s < 4; ++s) ak_n[s] = *(const bf16x8*)(kp + 16 * s + 8 * h);
    for (int c = 0; c < 4; ++c) vv_n[c] = *(const u32x4*)(kp + 768 + h * 32 + c * 8);
  }
#pragma nounroll
  for (int u = u_first; u < u_end; u += u_step) {
    long tbase; int q0, H, dil, j0; DIL_DECODE(u, tbase, q0, H, dil, j0)
    u16* qp = proj + (tbase + (long)(q0 + l31) * dil) * INW + O1 + H * 64;
    bf16x8 bq[4];
    for (int s = 0; s < 4; ++s) bq[s] = bq_n[s];
    f32x16 O[2]; for (int e = 0; e < 2; ++e) for (int i = 0; i < 16; ++i) O[e][i] = 0.f;
    float mrun = -1e30f, lsum = 0.f;
    const float* bt = btab + H * 132;
    const u16* kbase_ = proj + tbase * INW + O1 + 768 + H * 64;
    f32x16 sacc; for (int i = 0; i < 16; ++i) sacc[i] = 0.f;
    for (int s = 0; s < 4; ++s) sacc = MFMA32(ak_n[s], bq[s], sacc);
    u32x4 vv[4];
    for (int c = 0; c < 4; ++c) vv[c] = vv_n[c];
    if (j0 + 1 < 5) {
      const u16* kp = kbase_ + (long)(q0 - 128 + 32 * (j0 + 1) + l31) * dil * INW;
      for (int s = 0; s < 4; ++s) ak_n[s] = *(const bf16x8*)(kp + 16 * s + 8 * h);
      for (int c = 0; c < 4; ++c) vv_n[c] = *(const u32x4*)(kp + 768 + h * 32 + c * 8);
    }
#pragma nounroll
    for (int j = j0; j < 5; ++j) {
      const int kb = q0 - 128 + 32 * j;
      for (int c = 0; c < 4; ++c) *(u32x4*)(vbuf + l31 * 144 + h * 64 + c * 16) = vv[c];
      f32x16 snx; for (int i = 0; i < 16; ++i) snx[i] = 0.f;
      if (j + 1 < 5) {
        for (int s = 0; s < 4; ++s) snx = MFMA32(ak_n[s], bq[s], snx);
        for (int c = 0; c < 4; ++c) vv[c] = vv_n[c];
        if (j + 2 < 5) {
          const u16* kp = kbase_ + (long)(kb + 64 + l31) * dil * INW;
          for (int s = 0; s < 4; ++s) ak_n[s] = *(const bf16x8*)(kp + 16 * s + 8 * h);
          for (int c = 0; c < 4; ++c) vv_n[c] = *(const u32x4*)(kp + 768 + h * 32 + c * 8);
        }
      }
      if (j == 4 && u + u_step < u_end) {
        long tb2; int q02, H2, dil2, j02; DIL_DECODE(u + u_step, tb2, q02, H2, dil2, j02)
        const u16* qp2 = proj + (tb2 + (long)(q02 + l31) * dil2) * INW + O1 + H2 * 64;
        for (int s = 0; s < 4; ++s) bq_n[s] = *(const bf16x8*)(qp2 + 16 * s + 8 * h);
        const u16* kp = proj + (tb2 + (long)(q02 - 128 + 32 * j02 + l31) * dil2) * INW + O1 + 768 + H2 * 64;
        for (int s = 0; s < 4; ++s) ak_n[s] = *(const bf16x8*)(kp + 16 * s + 8 * h);
        for (int c = 0; c < 4; ++c) vv_n[c] = *(const u32x4*)(kp + 768 + h * 32 + c * 8);
      }
      float mx = -1e30f;
      for (int i = 0; i < 16; ++i) {
        int dist = (q0 + l31) - (kb + crow(i, h));
        bool ok = (dist >= 0) && (dist <= 128);
        int di = min(max(dist, 0), 128);
        float s2 = sacc[i] * sc + bt[di];
        s2 = ok ? s2 : -1e30f;
        sacc[i] = s2; mx = fmaxf(mx, s2);
      }
      mx = fmaxf(mx, shflx(mx, 32, lane));
      float mnew = fmaxf(mrun, mx);
      float alpha = fexp2(mrun - mnew);
      float ps = 0.f;
      for (int i = 0; i < 16; ++i) { float pv = sacc[i] > -1e29f ? fexp2(sacc[i] - mnew) : 0.f; sacc[i] = pv; ps += pv; }
      lsum = lsum * alpha + ps; mrun = mnew;
      for (int e = 0; e < 2; ++e) for (int i = 0; i < 16; ++i) O[e][i] *= alpha;
      __builtin_amdgcn_wave_barrier();
      for (int s = 0; s < 2; ++s) {
        bf16x8 pf = packP(sacc, s);
        for (int e = 0; e < 2; ++e) {
          s16x4 lo = tr_read(vbuf + (16 * s + 4 * h + tq) * 144 + e * 64 + 32 * blk + 8 * tp);
          s16x4 hi = tr_read(vbuf + (16 * s + 8 + 4 * h + tq) * 144 + e * 64 + 32 * blk + 8 * tp);
          bf16x8 av = __builtin_shufflevector(lo, hi, 0, 1, 2, 3, 4, 5, 6, 7);
          O[e] = MFMA32(av, pf, O[e]);
        }
      }
      __builtin_amdgcn_wave_barrier();
      sacc = snx;
    }
    float ltot = lsum + shflx(lsum, 32, lane);
    float inv = 1.f / ltot;
    for (int e = 0; e < 2; ++e) for (int gq = 0; gq < 4; ++gq) {
      f32x4 o4 = {O[e][4 * gq] * inv, O[e][4 * gq + 1] * inv, O[e][4 * gq + 2] * inv, O[e][4 * gq + 3] * inv};
      store4bf(qp + 32 * e + 8 * gq + 4 * h, o4);
    }
    if (h == 0) lse[(tbase + (long)(q0 + l31) * dil) * 12 + H] = (mrun + flog2(ltot)) * 0.6931471805599453f;
  }
}

DI void mix_dil_merge(WVP u16* __restrict__ proj, const float* __restrict__ lse) {
  const int BID = get_bid(), GRD = get_grid();
  const int tid = get_tid(WV);
  for (long idx = (long)BID * NTHR + tid; idx < (long)TOK * 32; idx += (long)GRD * NTHR) {
    int c8 = (int)(idx & 7), j = (int)(idx >> 3) & 3; long tok = idx >> 5;
    float l0 = lse[tok * 12 + j], l1 = lse[tok * 12 + 4 + j], l2 = lse[tok * 12 + 8 + j];
    float m = fmaxf(l0, fmaxf(l1, l2));
    float e0 = __expf(l0 - m), e1 = __expf(l1 - m), e2 = __expf(l2 - m), inv = 1.f / (e0 + e1 + e2);
    e0 *= inv; e1 *= inv; e2 *= inv;
    u16* base = proj + tok * INW + O1 + j * 64 + c8 * 8;
    uint4 a = *(const uint4*)base, b = *(const uint4*)(base + 256), c = *(const uint4*)(base + 512), o;
    o.x = pack2(e0 * bflo(a.x) + e1 * bflo(b.x) + e2 * bflo(c.x), e0 * bfhi(a.x) + e1 * bfhi(b.x) + e2 * bfhi(c.x));
    o.y = pack2(e0 * bflo(a.y) + e1 * bflo(b.y) + e2 * bflo(c.y), e0 * bfhi(a.y) + e1 * bfhi(b.y) + e2 * bfhi(c.y));
    o.z = pack2(e0 * bflo(a.z) + e1 * bflo(b.z) + e2 * bflo(c.z), e0 * bfhi(a.z) + e1 * bfhi(b.z) + e2 * bfhi(c.z));
    o.w = pack2(e0 * bflo(a.w) + e1 * bflo(b.w) + e2 * bflo(c.w), e0 * bfhi(a.w) + e1 * bfhi(b.w) + e2 * bfhi(c.w));
    *(uint4*)base = o;
  }
}

DI void mix_sb(WVP u16* __restrict__ proj, char* smem) {
  const int BID = get_bid(), GRD = get_grid();
  const int tid = get_tid(WV), wave = wave_of(tid), lane = tid & 63, h = lane >> 5, l31 = lane & 31;
  constexpr int RS = 272, TB = 32 * RS;
  char* kbuf = smem; char* vbuf = smem + 2 * TB; int* flags = (int*)(smem + 4 * TB);
  const int i16 = lane & 15, tq = i16 >> 2, tp = i16 & 3, blk = (lane >> 4) & 1;
  const float sc = 1.44269504089f * 0.08838834764831845f;
  const float RTH = -60.f;
  const int lrow = tid >> 4, lch = tid & 15;
  for (int it = BID; it < BATCH * 4 * 16; it += GRD) {
    int qb = 15 - (it & 15), hh = (it >> 4) & 3, b = it >> 6;
    int Q0 = qb * 256;
    u16* base = proj + (long)b * SEQ * INW + O2 + hh * 128;
    u16* qp = base + (long)(Q0 + 32 * wave + l31) * INW;
    bf16x8 bq[8];
    for (int s = 0; s < 8; ++s) bq[s] = *(const bf16x8*)(qp + 16 * s + 8 * h);
    f32x16 O[4]; for (int e = 0; e < 4; ++e) for (int i = 0; i < 16; ++i) O[e][i] = 0.f;
    float R = 0.f;
    const int kt_hi = Q0 / 32 + 7, kt_diag = Q0 / 32 + wave;
    __syncthreads();
    if (tid < 16) flags[tid] = 0;
    {
      const u16* kp = base + 512 + (long)(kt_hi * 32 + lrow) * INW + lch * 8;
      uint4 kv = *(const uint4*)kp, vv = *(const uint4*)(kp + 512);
      *(uint4*)(kbuf + lrow * RS + lch * 16) = kv; *(uint4*)(vbuf + lrow * RS + lch * 16) = vv;
    }
    __syncthreads();
    int cur = 0, iter = 0;
    for (int kt = kt_hi; kt >= 0; --kt, ++iter) {
      uint4 kv, vv;
      const bool more = kt > 0;
      if (more) { const u16* kp = base + 512 + (long)((kt - 1) * 32 + lrow) * INW + lch * 8; kv = *(const uint4*)kp; vv = *(const uint4*)(kp + 512); }
      bool wdone = false;
      if (kt <= kt_diag) {
        const char* kb_ = kbuf + cur * TB; const char* vb_ = vbuf + cur * TB;
        f32x16 sacc; for (int i = 0; i < 16; ++i) sacc[i] = 0.f;
        for (int s = 0; s < 8; ++s) { bf16x8 ak = *(const bf16x8*)(kb_ + l31 * RS + 32 * s + 16 * h); sacc = MFMA32(ak, bq[s], sacc); }
        const bool diag = (kt == kt_diag);
        float ls[16];
        for (int i = 0; i < 16; ++i) {
          float z2 = sacc[i] * sc;
          float sp = fmaxf(z2, 0.f) + flog2(1.f + fexp2(-fabsf(z2)));
          bool ok = !diag || (crow(i, h) < l31);
          ls[i] = ok ? -sp : 0.f;
          sacc[i] = ok ? z2 : -1e30f;
        }
        float G[4], Gp[4], tot[4];
        for (int g = 0; g < 4; ++g) G[g] = (ls[4 * g] + ls[4 * g + 1]) + (ls[4 * g + 2] + ls[4 * g + 3]);
        for (int g = 0; g < 4; ++g) { Gp[g] = shflx(G[g], 32, lane); tot[g] = G[g] + Gp[g]; }
        float after = 0.f;
        for (int g = 3; g >= 0; --g) {
          float tail = R + after + (h == 0 ? Gp[g] : 0.f);
          float c3 = tail + ls[4 * g + 3], c2 = c3 + ls[4 * g + 2], c1 = c2 + ls[4 * g + 1], c0 = c1 + ls[4 * g];
          sacc[4 * g + 3] = fexp2(sacc[4 * g + 3] + c3); sacc[4 * g + 2] = fexp2(sacc[4 * g + 2] + c2);
          sacc[4 * g + 1] = fexp2(sacc[4 * g + 1] + c1); sacc[4 * g] = fexp2(sacc[4 * g] + c0);
          after += tot[g];
        }
        R += after;
        for (int s = 0; s < 2; ++s) {
          bf16x8 pf = packP(sacc, s);
          for (int e = 0; e < 4; ++e) {
            s16x4 lo = tr_read(vb_ + (16 * s + 4 * h + tq) * RS + e * 64 + 32 * blk + 8 * tp);
            s16x4 hi = tr_read(vb_ + (16 * s + 8 + 4 * h + tq) * RS + e * 64 + 32 * blk + 8 * tp);
            bf16x8 av = __builtin_shufflevector(lo, hi, 0, 1, 2, 3, 4, 5, 6, 7);
            O[e] = MFMA32(av, pf, O[e]);
          }
        }
        wdone = __all(R < RTH);
      }
      if (lane == 0) flags[(iter & 1) * 8 + wave] = wdone ? 1 : 0;
      if (more) { *(uint4*)(kbuf + (cur ^ 1) * TB + lrow * RS + lch * 16) = kv; *(uint4*)(vbuf + (cur ^ 1) * TB + lrow * RS + lch * 16) = vv; }
      __syncthreads();
      cur ^= 1;
      int nd = 0;
      for (int w2 = 0; w2 < 8; ++w2) nd += flags[(iter & 1) * 8 + w2];
      if (nd == 8) break;
    }
    for (int e = 0; e < 4; ++e) for (int gq = 0; gq < 4; ++gq) {
      f32x4 o4 = {O[e][4 * gq], O[e][4 * gq + 1], O[e][4 * gq + 2], O[e][4 * gq + 3]};
      store4bf(qp + 32 * e + 8 * gq + 4 * h, o4);
    }
  }
}

DI void mix_s5(WVP CP pp, int l, u16* __restrict__ proj, char* smem) {
  const int BID = get_bid(), GRD = get_grid();
  const int tid = get_tid(WV), wave = wave_of(tid), lane = tid & 63, h = lane >> 5, l31 = lane & 31;
  constexpr int RSF = 132;
  float* buf = (float*)smem + wave * 32 * RSF;
  float* hend = (float*)(smem + 8 * 32 * RSF * 4);
  for (int it = BID; it < BATCH * 32; it += GRD) {
    const int g = it & 31, b = it >> 5;
    const float* a_re = pp->in[6] + ((size_t)l * 32 + g) * 64;
    const float* a_im = pp->in[7] + ((size_t)l * 32 + g) * 64;
    const float dt = __expf(pp->in[8][l * 32 + g]);
    const float* b_re = pp->in[9] + ((size_t)l * 32 + g) * 64 * 16;
    const float* b_im = pp->in[10] + ((size_t)l * 32 + g) * 64 * 16;
    const float* c_re = pp->in[11] + ((size_t)l * 32 + g) * 16 * 64;
    const float* c_im = pp->in[12] + ((size_t)l * 32 + g) * 16 * 64;
    const float* dsk = pp->in[13] + (size_t)l * 512 + g * 16;
    float lr, li;
    { float ar = a_re[lane], ai = a_im[lane]; float mg = expf(ar * dt); float sn, cs; sincosf(ai * dt, &sn, &cs); lr = mg * cs; li = mg * sn; }
    bf16x8 bfrag[4];
    float lam_r[2], lam_i[2];
    for (int half = 0; half < 2; ++half) {
      int ps = 32 * half + l31;
      float ar = a_re[ps], ai = a_im[ps]; float mg = expf(ar * dt); float sn, cs; sincosf(ai * dt, &sn, &cs);
      lam_r[half] = mg * cs; lam_i[half] = mg * sn;
      float xr = mg * cs - 1.f, xi = mg * sn, den = 1.f / (ar * ar + ai * ai);
      float cr = (xr * ar + xi * ai) * den, ci = (xi * ar - xr * ai) * den;
      float vr[8], vi[8];
      for (int j = 0; j < 8; ++j) { float br = b_re[ps * 16 + 8 * h + j], bi = b_im[ps * 16 + 8 * h + j]; vr[j] = cr * br - ci * bi; vi[j] = cr * bi + ci * br; }
      uint4 a = {pack2(vr[0], vr[1]), pack2(vr[2], vr[3]), pack2(vr[4], vr[5]), pack2(vr[6], vr[7])};
      uint4 c = {pack2(vi[0], vi[1]), pack2(vi[2], vi[3]), pack2(vi[4], vi[5]), pack2(vi[6], vi[7])};
      bfrag[half] = __builtin_bit_cast(bf16x8, a); bfrag[2 + half] = __builtin_bit_cast(bf16x8, c);
    }
    bf16x8 cfrag[4];
    { int c = lane & 15, kq = lane >> 4;
      for (int s = 0; s < 4; ++s) {
        float v[8];
        for (int j = 0; j < 8; ++j) { int k = 32 * s + 8 * kq + j; v[j] = k < 64 ? c_re[c * 64 + k] : -c_im[c * 64 + k - 64]; }
        uint4 a = {pack2(v[0], v[1]), pack2(v[2], v[3]), pack2(v[4], v[5]), pack2(v[6], v[7])};
        cfrag[s] = __builtin_bit_cast(bf16x8, a);
      } }
    const float dskip = dsk[lane & 15];
    u16* ub = proj + ((long)b * SEQ + wave * 512) * INW + O3 + g * 16;
    float hr = 0.f, hi = 0.f;
    __syncthreads();
    if (wave < 7) {
      float Hr[2] = {0.f, 0.f}, Hi[2] = {0.f, 0.f};
      float wre[2][16], wim[2][16], l32r[2], l32i[2];
      for (int half = 0; half < 2; ++half) {
        const float ar = lam_r[half], ai = lam_i[half];
        const float l2r = ar * ar - ai * ai, l2i = 2.f * ar * ai;
        const float l4r = l2r * l2r - l2i * l2i, l4i = 2.f * l2r * l2i;
        const float l5r = l4r * ar - l4i * ai, l5i = l4r * ai + l4i * ar;
        const float l8r = l4r * l4r - l4i * l4i, l8i = 2.f * l4r * l4i;
        const float l16r = l8r * l8r - l8i * l8i, l16i = 2.f * l8r * l8i;
        l32r[half] = l16r * l16r - l16i * l16i; l32i[half] = 2.f * l16r * l16i;
        float cr = h ? 1.f : l4r, ci = h ? 0.f : l4i;
#pragma unroll
        for (int i = 15; i >= 0; --i) {
          wre[half][i] = cr; wim[half][i] = ci;
          const float mr = (i & 3) ? ar : l5r, mi = (i & 3) ? ai : l5i;
          const float nr = cr * mr - ci * mi, ni = cr * mi + ci * mr; cr = nr; ci = ni;
        }
      }
      bf16x8 au_n = *(const bf16x8*)(ub + (long)l31 * INW + 8 * h);
      f32x16 z; for (int i = 0; i < 16; ++i) z[i] = 0.f;
#pragma nounroll
      for (int ch = 0; ch < 16; ++ch) {
        const bf16x8 au = au_n;
        if (ch + 1 < 16) au_n = *(const bf16x8*)(ub + (long)((ch + 1) * 32 + l31) * INW + 8 * h);
#pragma unroll
        for (int half = 0; half < 2; ++half) {
          const f32x16 bre = MFMA32(au, bfrag[half], z), bim = MFMA32(au, bfrag[2 + half], z);
          float sr = 0.f, si = 0.f;
#pragma unroll
          for (int i = 0; i < 16; ++i) { sr += wre[half][i] * bre[i] - wim[half][i] * bim[i]; si += wre[half][i] * bim[i] + wim[half][i] * bre[i]; }
          sr += shflx(sr, 32, lane); si += shflx(si, 32, lane);
          const float nr = l32r[half] * Hr[half] - l32i[half] * Hi[half] + sr, ni = l32r[half] * Hi[half] + l32i[half] * Hr[half] + si;
          Hr[half] = nr; Hi[half] = ni;
        }
      }
      if (h == 0) {
        hend[wave * 128 + l31] = Hr[0]; hend[wave * 128 + 64 + l31] = Hi[0];
        hend[wave * 128 + 32 + l31] = Hr[1]; hend[wave * 128 + 96 + l31] = Hi[1];
      }
    }
    __syncthreads();
    for (int pass = 1; pass < 2; ++pass) {
      if (pass == 1) {
        float pr_ = lr, pi_ = li;
        for (int k = 0; k < 9; ++k) { float nr = pr_ * pr_ - pi_ * pi_, ni = 2.f * pr_ * pi_; pr_ = nr; pi_ = ni; }
        hr = 0.f; hi = 0.f;
        for (int v = 0; v < wave; ++v) { float er = hend[v * 128 + lane], ei = hend[v * 128 + 64 + lane]; float nr = pr_ * hr - pi_ * hi + er, ni = pr_ * hi + pi_ * hr + ei; hr = nr; hi = ni; }
      }
      if (pass == 1 || wave < 7) {
        const int cch = lane & 15, kqq = lane >> 4;
        bf16x8 au_n = *(const bf16x8*)(ub + (long)l31 * INW + 8 * h);
        u16 us_n[8] = {0, 0, 0, 0, 0, 0, 0, 0};
        if (pass == 1) for (int q = 0; q < 8; ++q) us_n[q] = ub[(long)(16 * (q >> 2) + 4 * kqq + (q & 3)) * INW + cch];
#pragma nounroll
        for (int ch = 0; ch < 16; ++ch) {
          u16* up = ub + (long)(ch * 32) * INW;
          const bf16x8 au = au_n;
          u16 us[8];
          for (int q = 0; q < 8; ++q) us[q] = us_n[q];
          if (ch + 1 < 16) {
            const u16* un = up + (long)32 * INW;
            au_n = *(const bf16x8*)(un + (long)l31 * INW + 8 * h);
            if (pass == 1) for (int q = 0; q < 8; ++q) us_n[q] = un[(long)(16 * (q >> 2) + 4 * kqq + (q & 3)) * INW + cch];
          }
          f32x16 z; for (int i = 0; i < 16; ++i) z[i] = 0.f;
          for (int nt = 0; nt < 4; ++nt) {
            f32x16 bu = MFMA32(au, bfrag[nt], z);
            for (int i = 0; i < 16; ++i) buf[crow(i, h) * RSF + (nt >> 1) * 64 + (nt & 1) * 32 + l31] = bu[i];
          }
          __builtin_amdgcn_wave_barrier();
          {
            float sre[32], sim[32];
#pragma unroll
            for (int t = 0; t < 32; ++t) { sre[t] = buf[t * RSF + lane]; sim[t] = buf[t * RSF + 64 + lane]; }
#pragma unroll
            for (int t = 0; t < 32; ++t) {
              float nr = lr * hr - li * hi + sre[t], ni = lr * hi + li * hr + sim[t]; hr = nr; hi = ni; sre[t] = hr; sim[t] = hi;
            }
            if (pass == 1) {
#pragma unroll
              for (int t = 0; t < 32; ++t) { buf[t * RSF + lane] = sre[t]; buf[t * RSF + 64 + lane] = sim[t]; }
            }
          }
          __builtin_amdgcn_wave_barrier();
          if (pass == 1) {
            for (int mt = 0; mt < 2; ++mt) {
              f32x4 y = {0.f, 0.f, 0.f, 0.f};
              for (int s2 = 0; s2 < 4; ++s2) {
                const float* hp = buf + (16 * mt + cch) * RSF + 32 * s2 + 8 * kqq;
                f32x4 x0 = *(const f32x4*)hp, x1 = *(const f32x4*)(hp + 4);
                uint4 a = {pack2(x0[0], x0[1]), pack2(x0[2], x0[3]), pack2(x1[0], x1[1]), pack2(x1[2], x1[3])};
                y = MFMA16(__builtin_bit_cast(bf16x8, a), cfrag[s2], y);
              }
              for (int j = 0; j < 4; ++j) {
                int t = 16 * mt + 4 * kqq + j;
                float yv = y[j] + dskip * bf2f(us[4 * mt + j]);
                up[(long)t * INW + cch] = f2bf(gelu_tanh(yv));
              }
            }
            __builtin_amdgcn_wave_barrier();
          }
        }
      }
      if (pass == 0) { hend[wave * 128 + lane] = hr; hend[wave * 128 + 64 + lane] = hi; __syncthreads(); }
    }
    __syncthreads();
  }
}


#define XB_TMO      128
#define XB_XCNT(j)  (256  + 64 * (j))
#define XB_XSUB(j)  (1280 + 64 * (j))
#define XB_XGEN(j)  (2304 + 64 * (j))
#define XB_TOP      3328
#define XB_TOPGEN   3392
#define XCD_BAR_WORDS 3456
#define XB_SPIN_CAP (1u << 22)
DI unsigned xb_ld(unsigned* p)              { return __hip_atomic_load(p, __ATOMIC_RELAXED, __HIP_MEMORY_SCOPE_AGENT); }
DI unsigned xb_add(unsigned* p, unsigned v) { return __hip_atomic_fetch_add(p, v, __ATOMIC_RELAXED, __HIP_MEMORY_SCOPE_AGENT); }
DI unsigned xb_xcc_id() { return (unsigned)__builtin_amdgcn_s_getreg((3 << 11) | 20) & 0xFu; }
#define XB_SPIN(cond, bar) do { unsigned _sp = 0; while (cond) { __builtin_amdgcn_s_sleep(1); \
    if ((++_sp & 255u) == 0u) { if (xb_ld(&(bar)[XB_TMO])) break; if (_sp > XB_SPIN_CAP) { atomicAdd(&(bar)[XB_TMO], 1u); break; } } } } while (0)
struct XcdBarrier { unsigned* bar; unsigned x; volatile LAS unsigned* st; };
DI XcdBarrier xcd_barrier_post(unsigned* bar, volatile LAS unsigned* st) {
  XcdBarrier b; b.bar = bar; b.x = xb_xcc_id(); b.st = st;
  if (threadIdx.x == 0) (void)xb_add(&bar[XB_XCNT(b.x)], 1u);
  return b;
}
DI void xcd_barrier_complete(unsigned* bar, unsigned x, unsigned& nloc, unsigned& nx) {
  const unsigned G = gridDim.x * gridDim.y * gridDim.z;
  unsigned sum, cnt, mine, sp = 0u;
  for (;;) {
    sum = 0u; cnt = 0u; mine = 0u;
#pragma unroll
    for (unsigned j = 0; j < 16; ++j) { const unsigned c = xb_ld(&bar[XB_XCNT(j)]); sum += c; cnt += (c > 0u) ? 1u : 0u; mine = (j == x) ? c : mine; }
    if (sum == G) break;
    __builtin_amdgcn_s_sleep(1);
    if ((++sp & 255u) == 0u) { if (xb_ld(&bar[XB_TMO])) break; if (sp > XB_SPIN_CAP) { atomicAdd(&bar[XB_TMO], 1u); break; } }
  }
  nloc = mine > 0u ? mine : 1u; nx = cnt > 0u ? cnt : 1u;
}
DI void xcd_barrier(const XcdBarrier& b) {
  asm volatile("s_waitcnt vmcnt(0)" ::: "memory");
  __syncthreads();
  if (threadIdx.x == 0) {
    unsigned* bar = b.bar;
    __builtin_amdgcn_s_waitcnt(0);
    unsigned nloc = b.st[0], nx = b.st[1];
    if (nloc == 0u) { xcd_barrier_complete(bar, b.x, nloc, nx); b.st[0] = nloc; b.st[1] = nx; }
    const unsigned old = xb_add(&bar[XB_XSUB(b.x)], 1u);
    const unsigned gen = old / nloc;
    if (old + 1u == (gen + 1u) * nloc) {
      __builtin_amdgcn_fence(__ATOMIC_RELEASE, "agent");
      asm volatile("s_waitcnt vmcnt(0)" ::: "memory");
      const unsigned og = xb_add(&bar[XB_TOP], 1u);
      const unsigned tg = og / nx;
      if (og + 1u == (tg + 1u) * nx) xb_add(&bar[XB_TOPGEN], 1u);
      else XB_SPIN(xb_ld(&bar[XB_TOPGEN]) == tg, bar);
      __builtin_amdgcn_fence(__ATOMIC_ACQUIRE, "agent");
      xb_add(&bar[XB_XGEN(b.x)], 1u);
      asm volatile("s_waitcnt vmcnt(0)" ::: "memory");
    } else {
      XB_SPIN(xb_ld(&bar[XB_XGEN(b.x)]) == gen, bar);
      __builtin_amdgcn_fence(__ATOMIC_ACQUIRE, "agent");
      asm volatile("s_waitcnt vmcnt(0)" ::: "memory");
    }
  }
  __syncthreads();
}

__global__ void __launch_bounds__(NTHR) mega(Params p) {
  extern __shared__ __attribute__((aligned(16))) char smem[];

  const int ph_lo = p.ph_lo, ph_hi = p.ph_hi;
  const int WV = __builtin_amdgcn_readfirstlane(threadIdx.x >> 6);
  volatile LAS unsigned* xst = (volatile LAS unsigned*)(smem + LDS_BYTES - 16);
  if (threadIdx.x == 0) { xst[0] = 0u; xst[1] = 0u; }
  __syncthreads();
  (void)xcd_barrier_post((unsigned*)(p.ws + WS_BAR), xst);
  for (int ph = ph_lo; ph < ph_hi; ++ph) {
    if (ph % PH_PER_LAYER == 6) continue;
    if (ph == ph_lo + 1) cg::this_grid().sync();
    else if (ph > ph_lo) {
      CP pb_ = (CP)__builtin_amdgcn_kernarg_segment_ptr(); asm volatile("" : "+s"(pb_));
      XcdBarrier xbar; xbar.bar = (unsigned*)(pb_->ws + WS_BAR); xbar.x = xb_xcc_id(); xbar.st = (volatile LAS unsigned*)(smem + LDS_BYTES - 16);
      xcd_barrier(xbar);
    }
    const int BID = get_bid(), G = get_grid();
    CP pp = (CP)__builtin_amdgcn_kernarg_segment_ptr(); asm volatile("" : "+s"(pp));
    char* ws = pp->ws;
    u16* proj = (u16*)(ws + WS_PROJ);
    u16* xn = (u16*)(ws + WS_XN);
    u16* pb = (u16*)(ws + WS_PB);
    u16* mg = (u16*)(ws + WS_MG);
    float* lse = (float*)(ws + WS_LSE);
    u16* hbuf = proj;
    const u16* WIN = (const u16*)(ws + WS_WIN); const u16* WG = (const u16*)(ws + WS_WG); const u16* WB = (const u16*)(ws + WS_WB);
    const u16* WO = (const u16*)(ws + WS_WO); const u16* WUP = (const u16*)(ws + WS_WUP); const u16* WDN = (const u16*)(ws + WS_WDN);
    const u16* WGLU = (const u16*)(ws + WS_WGLU);
    float* xres = pp->out;
    const int l = ph / PH_PER_LAYER, k = ph % PH_PER_LAYER;
    const float* xin = (l == 0) ? pp->in[0] : xres;
    switch (k) {
      case 0: {
        if (l == 0) phase_rmsnorm(WV, xin, pp->in[1] + (size_t)l * DM, xn);
        phase_wprep(WV, pp, l, smem);
      } break;
      case 1: {
        const int nR = INW / 256, nC = TOK / 256, nwg = nR * nC;
        for (int id = BID; id < nwg; id += G) {
          int pr, pc; tile_map(id, nwg, nR, nC, pr, pc);
          EpiStore2 E{proj, INW, pr * 256, pr * 256 + 128};
          gemm_tile_staged(WV, smem, WIN, DM, pr * 256, pr * 256 + 128, xn, DM, pc * 256, DM, E);
        }
      } break;
      case 2: {
        mix_s5(WV, pp, l, proj, smem);
        mix_sb(WV, proj, smem);
        mix_dil(WV, proj, lse, pp->in[5], smem);
        mix_pool(WV, proj, pb);
      } break;
      case 3: {
        const int nR = 4, nC = TOK / 256, nwg = nR * nC;
        for (int id = BID; id < nwg; id += G) {
          int pr, pc; tile_map(id, nwg, nR, nC, pr, pc);
          EpiGated<1> E{proj, INW, O2 + 512 + pr * 128};
          gemm_tile_staged(WV, smem, WGLU, 512, pr * 128, 512 + pr * 128, proj + O3, INW, pc * 256, 512, E);
        }
        mix_dil_merge(WV, proj, lse);
      } break;
      case 4: {
        const int nR = 4, nC = TOK / 256, nwg = nR * nC;
        for (int id = BID; id < nwg; id += G) {
          int pr, pc; tile_map(id, nwg, nR, nC, pr, pc);
#pragma nounroll
          for (int b = 0; b < 4; ++b) {
            const int q = pr * 3 + b;
            u16* sd = (b == 3) ? mg + pr * 256 : proj + (q < 8 ? 768 + 256 * q : (q < 10 ? 256 * (q - 8) : 3840 + 256 * (q - 10)));
            EpiSig E1{sd, b == 3 ? DM : INW, pc * 256};
            gemm_tile(WV, smem, WG + (size_t)b * DM * DM, DM, pr * 256, pr * 256 + 128, xn, DM, pc * 256, DM, E1);
          }
          AccT acc = {};
#pragma nounroll
          for (int b = 0; b < 4; ++b) {
            const int Kb = (b == 1) ? 256 : 512, ldy = (b == 0) ? 512 : INW;
            const u16* yb = (b == 0) ? pb : proj + (b == 1 ? O1 : (b == 2 ? O2 : O2 + 512));
            const u16* wb = WB + DM * (b == 0 ? 0 : (b == 1 ? 512 : (b == 2 ? 768 : 1280)));
            gemm_core(WV, smem, wb, Kb, pr * 256, pr * 256 + 128, yb, ldy, pc * 256, Kb, acc);
            if (b < 3) {
              const int q = pr * 3 + b, q1 = q + 1;
              u16* sc = proj + (q < 8 ? 768 + 256 * q : (q < 10 ? 256 * (q - 8) : 3840 + 256 * (q - 10)));
              u16* sn = (b == 2) ? mg + pr * 256 : proj + (q1 < 8 ? 768 + 256 * q1 : (q1 < 10 ? 256 * (q1 - 8) : 3840 + 256 * (q1 - 10)));
              EpiRescale E2{sc, INW, sn, b == 2 ? DM : INW, pc * 256};
              apply_epi(WV, acc, pc * 256, E2);
            }
          }
          EpiFinalGate E3{mg, pr * 256, pc * 256};
          apply_epi_staged(WV, smem, acc, pc * 256, E3);
        }
      } break;
      case 5: {
        const int nR = 4, nC = TOK / 256, nwg = nR * nC;
        for (int id = BID; id < nwg; id += G) {
          int pr, pc; tile_map(id, nwg, nR, nC, pr, pc);
          AccT acc = {};
          gemm_core(WV, smem, WO, DM, pr * 256, pr * 256 + 128, mg, DM, pc * 256, DM, acc);
          resid_norm_epi(WV, smem, acc, pc * 256, xin, xres, pr * 256, pc, pr, (unsigned)(ph + 1), (u64*)(ws + WS_SLAB), pp->in[18] + (size_t)l * DM, xn, 1);
        }
      } break;
      case 7: {
        const int nR = FFN / 128, nC = TOK / 256, nwg = nR * nC;
        for (int id = BID; id < nwg; id += G) {
          int pr, pc; tile_map(id, nwg, nR, nC, pr, pc);
          EpiGated<0> E{hbuf, FFN, pr * 128};
          gemm_tile_staged(WV, smem, WUP, DM, pr * 128, FFN + pr * 128, xn, DM, pc * 256, DM, E);
        }
      } break;
      case 8: {
        const int nR = 4, nC = TOK / 256, nwg = nR * nC;
        for (int id = BID; id < nwg; id += G) {
          int pr, pc; tile_map(id, nwg, nR, nC, pr, pc);
          AccT acc = {};
          gemm_core(WV, smem, WDN, FFN, pr * 256, pr * 256 + 128, hbuf, FFN, pc * 256, FFN, acc);
          resid_norm_epi(WV, smem, acc, pc * 256, xres, xres, pr * 256, pc, pr, (unsigned)(ph + 1), (u64*)(ws + WS_SLAB), (l < DEPTH - 1) ? pp->in[1] + (size_t)(l + 1) * DM : pp->in[21], xn, (l < DEPTH - 1) ? 1 : 2);
        }
      } break;
    }
  }
}

extern "C" void kernel_launch(void* const* d_in, const int* in_sizes, int n_in, void* d_out, int out_size,
                              void* d_ws, size_t ws_size, hipStream_t stream) {
  static int grid = 0;
  if (grid == 0) {
    if (n_in != 22 || ws_size < WS_END) { fprintf(stderr, "kernel_launch: unexpected n_in %d / ws_size %zu (need %zu)\n", n_in, ws_size, (size_t)WS_END); grid = -1; return; }
    int dev = 0, cus = 0, per_cu = 0;
    hipGetDevice(&dev);
    hipDeviceGetAttribute(&cus, hipDeviceAttributeMultiprocessorCount, dev);
    if (hipFuncSetAttribute((const void*)mega, hipFuncAttributeMaxDynamicSharedMemorySize, LDS_BYTES) != hipSuccess) { fprintf(stderr, "hipFuncSetAttribute failed\n"); grid = -1; return; }
    if (hipOccupancyMaxActiveBlocksPerMultiprocessor(&per_cu, (const void*)mega, NTHR, LDS_BYTES) != hipSuccess || per_cu < 1) { fprintf(stderr, "occupancy query failed (%d)\n", per_cu); per_cu = 1; (void)hipGetLastError(); }
    grid = cus * per_cu;
  }
  if (grid < 0) return;
  if (hipMemsetAsync((char*)d_ws + WS_BAR, 0, WS_END - WS_BAR, stream) != hipSuccess) { fprintf(stderr, "memset of barrier words failed\n"); return; }
  Params p{};
  for (int i = 0; i < 22; ++i) p.in[i] = (const float*)d_in[i];
  p.out = (float*)d_out; p.ws = (char*)d_ws;
#if ONE_LAUNCH
  p.ph_lo = 0; p.ph_hi = N_PHASES;
  void* args[] = {&p};
  hipError_t e = hipLaunchCooperativeKernel((const void*)mega, dim3(grid), dim3(NTHR), args, LDS_BYTES, stream);
  if (e != hipSuccess) fprintf(stderr, "cooperative launch failed: %s (grid %d)\n", hipGetErrorString(e), grid);
#else
  for (int ph = 0; ph < N_PHASES; ++ph) {
    p.ph_lo = ph; p.ph_hi = ph + 1;
    hipLaunchKernelGGL(mega, dim3(grid), dim3(NTHR), LDS_BYTES, stream, p);
  }
#endif
}
```

```cpp
#include <hip/hip_runtime.h>
#include <hip/hip_bf16.h>
#include <hip/hip_cooperative_groups.h>
#include <cstdio>
namespace cg = cooperative_groups;

#ifndef ONE_LAUNCH
#define ONE_LAUNCH 1
#endif

typedef unsigned short u16;
using bf16x8 = __attribute__((ext_vector_type(8))) short;
using s16x4  = __attribute__((ext_vector_type(4))) short;
using f32x4  = __attribute__((ext_vector_type(4))) float;
using f32x16 = __attribute__((ext_vector_type(16))) float;
using u32x4  = __attribute__((ext_vector_type(4))) unsigned;
typedef __bf16 bf2_t __attribute__((ext_vector_type(2)));
typedef float f2_t __attribute__((ext_vector_type(2)));
#define DI __device__ __forceinline__
#define LAS __attribute__((address_space(3)))

constexpr int DM = 1024, BATCH = 8, SEQ = 4096, TOK = BATCH * SEQ, DEPTH = 4;
constexpr int INW = 4864, O1 = 512, O2 = 2816, O3 = 4352;
constexpr int FFN = 2816;
constexpr int NTHR = 512;
constexpr int LDS_BYTES = 147456;
constexpr int PH_PER_LAYER = 9, N_PHASES = DEPTH * PH_PER_LAYER;

constexpr size_t WS_PROJ = 0;
constexpr size_t WS_XN   = WS_PROJ + (size_t)TOK * INW * 2;
constexpr size_t WS_PB   = WS_XN + (size_t)TOK * DM * 2;
constexpr size_t WS_MG   = WS_PB + (size_t)TOK * 512 * 2;
constexpr size_t WS_LSE  = WS_MG + (size_t)TOK * DM * 2;
constexpr size_t WS_WIN  = WS_LSE + (size_t)TOK * 12 * 4;
constexpr size_t WS_WG   = WS_WIN + (size_t)INW * DM * 2;
constexpr size_t WS_WB   = WS_WG + (size_t)4 * DM * DM * 2;
constexpr size_t WS_WO   = WS_WB + (size_t)DM * 1792 * 2;
constexpr size_t WS_WUP  = WS_WO + (size_t)DM * DM * 2;
constexpr size_t WS_WDN  = WS_WUP + (size_t)2 * FFN * DM * 2;
constexpr size_t WS_WGLU = WS_WDN + (size_t)DM * FFN * 2;
constexpr size_t WS_BAR  = WS_WGLU + (size_t)DM * 512 * 2;
constexpr size_t WS_SLAB = WS_BAR + 16384;
constexpr size_t WS_END  = WS_SLAB + (size_t)128 * 4 * 256 * 8;

struct Params {
  const float* in[22];
  float* out;
  char* ws;
  int ph_lo, ph_hi;
};
typedef const Params __attribute__((address_space(4)))* CP;

DI unsigned pack2(float a, float b) { f2_t v = {a, b}; bf2_t r = __builtin_convertvector(v, bf2_t); return __builtin_bit_cast(unsigned, r); }
DI u16 f2bf(float a) { return (u16)(pack2(a, 0.f) & 0xffffu); }
DI float bf2f(u16 v) { return __uint_as_float(((unsigned)v) << 16); }
DI float bflo(unsigned v) { return __uint_as_float(v << 16); }
DI float bfhi(unsigned v) { return __uint_as_float(v & 0xffff0000u); }
DI void store4bf(u16* p, f32x4 a) { uint2 v; v.x = pack2(a[0], a[1]); v.y = pack2(a[2], a[3]); *(uint2*)p = v; }
DI f32x4 load4bf(const u16* p) { uint2 v = *(const uint2*)p; f32x4 r = {bflo(v.x), bfhi(v.x), bflo(v.y), bfhi(v.y)}; return r; }
DI float fexp2(float x) { return __builtin_amdgcn_exp2f(x); }
DI float flog2(float x) { return __builtin_amdgcn_logf(x); }
DI float frcp(float x) { return __builtin_amdgcn_rcpf(x); }
DI float sigmoidf_(float x) { return frcp(1.f + fexp2(-1.44269504089f * x)); }
DI float siluf_(float x) { return x * sigmoidf_(x); }
DI float gelu_tanh(float x) {
  float u = 0.7978845608028654f * (x + 0.044715f * x * x * x);
  float e = fexp2(2.885390081777927f * u);
  float th = 1.f - 2.f * frcp(1.f + e);
  return 0.5f * x * (1.f + th);
}
DI int get_tid(int wv) { int l; asm volatile("v_mbcnt_lo_u32_b32 %0, -1, 0\n\tv_mbcnt_hi_u32_b32 %0, -1, %0" : "=v"(l)); return wv * 64 + l; }
DI int get_bid() { int b = blockIdx.x; asm volatile("" : "+s"(b)); return b; }
DI int get_grid() { int g = gridDim.x; asm volatile("" : "+s"(g)); return g; }
DI int wave_of(int tid) { return __builtin_amdgcn_readfirstlane(tid >> 6); }
#define WVP const int WV,
DI float shflx(float v, int mask, int lane) { return __int_as_float(__builtin_amdgcn_ds_bpermute((lane ^ mask) << 2, __float_as_int(v))); }
DI int crow(int i, int h) { return (i & 3) + 8 * (i >> 2) + 4 * h; }
#define MFMA32(a, b, c) __builtin_amdgcn_mfma_f32_32x32x16_bf16((a), (b), (c), 0, 0, 0)
#define MFMA16(a, b, c) __builtin_amdgcn_mfma_f32_16x16x32_bf16((a), (b), (c), 0, 0, 0)
DI s16x4 tr_read(const char* p) { return __builtin_amdgcn_ds_read_tr16_b64_v4i16((LAS s16x4*)p); }
DI bf16x8 packP(const f32x16& x, int s) {
  unsigned a = pack2(x[8 * s], x[8 * s + 1]), b = pack2(x[8 * s + 2], x[8 * s + 3]);
  unsigned c = pack2(x[8 * s + 4], x[8 * s + 5]), d = pack2(x[8 * s + 6], x[8 * s + 7]);
  uint4 v = {a, b, c, d};
  return __builtin_bit_cast(bf16x8, v);
}

constexpr int BK = 64, HALF = 128, HT = HALF * BK;
DI int lds_byte(int r, int c) {
  int st = (r >> 4) * 2 + (c >> 5), rr = r & 15, cc = c & 31, ob = rr * 64 + cc * 2;
  return st * 1024 + (ob ^ (((ob >> 9) & 1) << 5));
}
DI void stage_rc(int b, int& R, int& C) {
  int st = b / 1024, sb = b % 1024, swz = sb ^ (((sb >> 9) & 1) << 5);
  R = (st >> 1) * 16 + swz / 64; C = (st & 1) * 32 + (swz % 64) / 2;
}

typedef f32x4 AccT[2][2][4][2];
DI void gemm_core(WVP char* smem, const u16* __restrict__ A, int lda, int ar0, int ar1,
                  const u16* __restrict__ B, int ldb, int bc0, int K, AccT& acc) {
  u16* shm = (u16*)smem;
#define SA(b, h) (shm + ((b) * 2 + (h)) * HT)
#define SB(b, h) (shm + (4 + (b) * 2 + (h)) * HT)
#define STAGE_A(P, br, kt) do { const char* _g = (const char*)(A + (long)(br) * lda + (long)(kt) * BK); \
    __builtin_amdgcn_global_load_lds((const unsigned*)(_g + (size_t)offA0), (unsigned*)((char*)(P) + sb0), 16, 0, 0); \
    __builtin_amdgcn_global_load_lds((const unsigned*)(_g + (size_t)lda * 128 + (size_t)offA0), (unsigned*)((char*)(P) + sb1), 16, 0, 0); } while (0)
#define STAGE_B(P, br, kt) do { const char* _g = (const char*)(B + (long)(br) * ldb + (long)(kt) * BK); \
    __builtin_amdgcn_global_load_lds((const unsigned*)(_g + (size_t)offB0), (unsigned*)((char*)(P) + sb0), 16, 0, 0); \
    __builtin_amdgcn_global_load_lds((const unsigned*)(_g + (size_t)ldb * 128 + (size_t)offB0), (unsigned*)((char*)(P) + sb1), 16, 0, 0); } while (0)
#define LDA(dst, b, h) for (int m = 0; m < 4; ++m) for (int k = 0; k < 2; ++k) \
    dst[m][k] = *reinterpret_cast<const bf16x8*>((char*)SA(b, h) + lds_byte(wr * 64 + m * 16 + fr, k * 32 + fq * 8))
#define LDB(dst, b, h) for (int n = 0; n < 2; ++n) for (int k = 0; k < 2; ++k) \
    dst[n][k] = *reinterpret_cast<const bf16x8*>((char*)SB(b, h) + lds_byte(wc * 32 + n * 16 + fr, k * 32 + fq * 8))
#define MMA(ai, bj, At_, Bt_) do { __builtin_amdgcn_s_setprio(1); \
    for (int m = 0; m < 4; ++m) for (int n = 0; n < 2; ++n) for (int k = 0; k < 2; ++k) \
      acc[ai][bj][m][n] = MFMA16(At_[m][k], Bt_[n][k], acc[ai][bj][m][n]); \
    __builtin_amdgcn_s_setprio(0); } while (0)
#define WAIT_V(n) asm volatile("s_waitcnt vmcnt(" #n ")" ::: "memory")
#define WAIT_L(n) asm volatile("s_waitcnt lgkmcnt(" #n ")" ::: "memory")
#define BAR __builtin_amdgcn_s_barrier()
#define SCHED __builtin_amdgcn_sched_barrier(0)

  const int tid = get_tid(WV);
  const int wid = wave_of(tid), lane = tid & 63, wr = wid >> 2, wc = wid & 3, fr = lane & 15, fq = lane >> 4;
  const int sb0 = tid * 16, sb1 = sb0 + 8192;
  int R0, C0; stage_rc(sb0, R0, C0);
  const unsigned offA0 = (unsigned)(R0 * lda + C0) * 2u, offB0 = (unsigned)(R0 * ldb + C0) * 2u;
  const int ac0 = ar0, ac1 = ar1, bb0 = bc0, bb1 = bc0 + HALF;
  bf16x8 At[4][2], B0[2][2], B1[2][2];
  const int nt = K / BK;
  __syncthreads();
  STAGE_B(SB(0, 0), bb0, 0); STAGE_A(SA(0, 0), ac0, 0);
  STAGE_B(SB(0, 1), bb1, 0); STAGE_A(SA(0, 1), ac1, 0);
  if (wr == 1) BAR;
  WAIT_V(4); BAR;
  STAGE_B(SB(1, 0), bb0, 1); STAGE_A(SA(1, 0), ac0, 1); STAGE_B(SB(1, 1), bb1, 1);
  WAIT_V(6); BAR;
  for (int t = 0; t < nt - 2; t += 2) {
    LDB(B0, 0, 0); SCHED; LDA(At, 0, 0); STAGE_A(SA(1, 1), ac1, t + 1);
    WAIT_L(8); BAR; WAIT_L(0); MMA(0, 0, At, B0); BAR; SCHED;
    LDB(B1, 0, 1); STAGE_B(SB(0, 0), bb0, t + 2);
    BAR; WAIT_L(0); MMA(0, 1, At, B1); BAR;
    LDA(At, 0, 1); STAGE_A(SA(0, 0), ac0, t + 2);
    BAR; WAIT_L(0); MMA(1, 0, At, B0); BAR; SCHED;
    STAGE_B(SB(0, 1), bb1, t + 2);
    WAIT_V(6); BAR; MMA(1, 1, At, B1); BAR;
    LDB(B0, 1, 0); SCHED; LDA(At, 1, 0); STAGE_A(SA(0, 1), ac1, t + 2);
    WAIT_L(8); BAR; WAIT_L(0); MMA(0, 0, At, B0); BAR; SCHED;
    LDB(B1, 1, 1); STAGE_B(SB(1, 0), bb0, t + 3);
    BAR; WAIT_L(0); MMA(0, 1, At, B1); BAR;
    LDA(At, 1, 1); STAGE_A(SA(1, 0), ac0, t + 3);
    BAR; WAIT_L(0); MMA(1, 0, At, B0); BAR; SCHED;
    STAGE_B(SB(1, 1), bb1, t + 3);
    WAIT_V(6); BAR; MMA(1, 1, At, B1); BAR;
  }
  { LDB(B0, 0, 0); LDA(At, 0, 0); STAGE_A(SA(1, 1), ac1, nt - 1);
    BAR; WAIT_L(0); MMA(0, 0, At, B0); BAR;
    LDB(B1, 0, 1); BAR; WAIT_L(0); MMA(0, 1, At, B1); BAR;
    LDA(At, 0, 1); WAIT_V(4); BAR; WAIT_L(0); MMA(1, 0, At, B0); MMA(1, 1, At, B1); BAR; }
  { LDB(B0, 1, 0); LDA(At, 1, 0); WAIT_V(2); BAR; WAIT_L(0); MMA(0, 0, At, B0); BAR;
    LDB(B1, 1, 1); WAIT_V(0); BAR; WAIT_L(0); MMA(0, 1, At, B1); BAR;
    LDA(At, 1, 1); BAR; WAIT_L(0); MMA(1, 0, At, B0); MMA(1, 1, At, B1); BAR; }
  if (wr == 0) BAR;
#undef SA
#undef SB
}
template <class Epi>
DI void apply_epi(WVP AccT& acc, int bc0, const Epi& epi) {
  const int t2 = get_tid(WV);
  const int wid2 = wave_of(t2), lane2 = t2 & 63, wr2 = wid2 >> 2, wc2 = wid2 & 3, fr2 = lane2 & 15, fq2 = lane2 >> 4;
  for (int bj = 0; bj < 2; ++bj) for (int m = 0; m < 4; ++m) {
    for (int n = 0; n < 2; ++n)
      epi(acc[0][bj][m][n], acc[1][bj][m][n], wr2 * 64 + m * 16 + fq2 * 4, bc0 + bj * HALF + wc2 * 32 + n * 16 + fr2, bj * 8 + m * 2 + n, t2);
    if (m & 1) __builtin_amdgcn_sched_barrier(0);
  }
}
template <class Epi>
DI void apply_epi_staged(WVP char* smem, AccT& acc, int bc0, const Epi& epi) {
  constexpr int NC = Epi::NC, PITCH = NC * 2 + 16;
  const int t2 = get_tid(WV);
  const int wid2 = wave_of(t2), lane2 = t2 & 63, wr2 = wid2 >> 2, wc2 = wid2 & 3, fr2 = lane2 & 15, fq2 = lane2 >> 4;
  for (int bj = 0; bj < 2; ++bj) for (int m = 0; m < 4; ++m) {
    for (int n = 0; n < 2; ++n) {
      const int rl = wr2 * 64 + m * 16 + fq2 * 4, tc = bj * HALF + wc2 * 32 + n * 16 + fr2;
      f32x4 r0, r1;
      epi.tr(acc[0][bj][m][n], acc[1][bj][m][n], rl, bc0 + tc, bj * 8 + m * 2 + n, t2, r0, r1);
      uint2 v0; v0.x = pack2(r0[0], r0[1]); v0.y = pack2(r0[2], r0[3]);
      *(uint2*)(smem + tc * PITCH + rl * 2) = v0;
      if (NC == 256) { uint2 v1; v1.x = pack2(r1[0], r1[1]); v1.y = pack2(r1[2], r1[3]); *(uint2*)(smem + tc * PITCH + (HALF + rl) * 2) = v1; }
    }
    if (m & 1) __builtin_amdgcn_sched_barrier(0);
  }
  __syncthreads();
  constexpr int CPR = NC / 8;
#pragma unroll
  for (int i = 0; i < 256 * CPR / NTHR; ++i) {
    const int L = i * NTHR + t2, row = L / CPR, ch = L % CPR;
    const u32x4 v = *(const u32x4*)(smem + row * PITCH + ch * 16);
    *(u32x4*)(epi.out(bc0 + row, ch)) = v;
  }
}
template <class Epi>
DI void gemm_tile(WVP char* smem, const u16* __restrict__ A, int lda, int ar0, int ar1,
                  const u16* __restrict__ B, int ldb, int bc0, int K, const Epi& epi) {
  AccT acc = {};
  gemm_core(WV, smem, A, lda, ar0, ar1, B, ldb, bc0, K, acc);
  apply_epi(WV, acc, bc0, epi);
}
template <class Epi>
DI void gemm_tile_staged(WVP char* smem, const u16* __restrict__ A, int lda, int ar0, int ar1,
                  const u16* __restrict__ B, int ldb, int bc0, int K, const Epi& epi) {
  AccT acc = {};
  gemm_core(WV, smem, A, lda, ar0, ar1, B, ldb, bc0, K, acc);
  apply_epi_staged(WV, smem, acc, bc0, epi);
}

DI void tile_map(int id, int nwg, int nR, int nC, int& pr, int& pc) {
  constexpr int NX = 8, WGM = 4;
  int q = nwg / NX, r = nwg % NX, xcd = id % NX, off = id / NX;
  id = (xcd < r ? xcd * (q + 1) : r * (q + 1) + (xcd - r) * q) + off;
  int nig = WGM * nC, gid = id / nig, fm = gid * WGM, gsz = min(nR - fm, WGM);
  pr = fm + ((id % nig) % gsz); pc = (id % nig) / gsz;
}

struct EpiStore2 { static constexpr int NC = 256; u16* dst; int ld; int n0, n1;
  DI void tr(const f32x4& a0, const f32x4& a1, int, int, int, int, f32x4& r0, f32x4& r1) const { r0 = a0; r1 = a1; }
  DI u16* out(int row, int ch) const { return dst + (long)row * ld + (ch < 16 ? n0 + ch * 8 : n1 + (ch - 16) * 8); } };
template <int ACT> struct EpiGated { static constexpr int NC = 128; u16* dst; int ld; int nb;
  DI void tr(const f32x4& a0, const f32x4& a1, int, int, int, int, f32x4& r0, f32x4& r1) const {
    for (int j = 0; j < 4; ++j) r0[j] = ACT == 0 ? siluf_(a0[j]) * a1[j] : a0[j] * sigmoidf_(a1[j]);
    r1 = r0; }
  DI u16* out(int row, int ch) const { return dst + (long)row * ld + nb + ch * 8; } };
struct EpiResid { const float* xin; float* xout; int n0, n1;
  DI void operator()(f32x4& a0, f32x4& a1, int rl, int col, int, int) const {
    f32x4 v0 = *(const f32x4*)(xin + (long)col * DM + n0 + rl), v1 = *(const f32x4*)(xin + (long)col * DM + n1 + rl);
    *(f32x4*)(xout + (long)col * DM + n0 + rl) = v0 + a0; *(f32x4*)(xout + (long)col * DM + n1 + rl) = v1 + a1; } };
DI u16* stash_ptr(u16* base, int ld, int bc0, int j, int tid) { const int L = j * NTHR + tid; return base + (long)(bc0 + (L >> 5)) * ld + (L & 31) * 8; }
DI void unpack8(const u32x4& v, f32x4& lo, f32x4& hi) { lo = f32x4{bflo(v[0]), bfhi(v[0]), bflo(v[1]), bfhi(v[1])}; hi = f32x4{bflo(v[2]), bfhi(v[2]), bflo(v[3]), bfhi(v[3])}; }
struct EpiSig { u16* dst; int ld; int bc0;
  DI void operator()(f32x4& a0, f32x4& a1, int, int, int j, int tid) const {
    f32x4 r0, r1;
    for (int q = 0; q < 4; ++q) { r0[q] = fmaxf(sigmoidf_(a0[q]), 1e-20f); r1[q] = fmaxf(sigmoidf_(a1[q]), 1e-20f); }
    u32x4 v = {pack2(r0[0], r0[1]), pack2(r0[2], r0[3]), pack2(r1[0], r1[1]), pack2(r1[2], r1[3])};
    *(u32x4*)stash_ptr(dst, ld, bc0, j, tid) = v; } };
struct EpiRescale { u16* sc; int ldc; u16* sn; int ldn; int bc0;
  DI void operator()(f32x4& a0, f32x4& a1, int, int, int j, int tid) const {
    const u32x4 vc = *(const u32x4*)stash_ptr(sc, ldc, bc0, j, tid), vn = *(const u32x4*)stash_ptr(sn, ldn, bc0, j, tid);
    f32x4 c0, c1, n0, n1; unpack8(vc, c0, c1); unpack8(vn, n0, n1);
    for (int q = 0; q < 4; ++q) { a0[q] *= c0[q] * frcp(n0[q]); a1[q] *= c1[q] * frcp(n1[q]); } } };
struct EpiFinalGate { static constexpr int NC = 256; u16* mg; int nbase; int bc0;
  DI void tr(const f32x4& a0, const f32x4& a1, int, int, int j, int tid, f32x4& r0, f32x4& r1) const {
    const u32x4 vc = *(const u32x4*)stash_ptr(mg + nbase, DM, bc0, j, tid);
    f32x4 c0, c1; unpack8(vc, c0, c1); r0 = a0 * c0; r1 = a1 * c1; }
  DI u16* out(int row, int ch) const { return mg + (long)row * DM + nbase + ch * 8; } };

typedef unsigned long long u64;
typedef __attribute__((address_space(1))) u64 gu64;
struct EpiNormOut { static constexpr int NC = 256; u16* xn; int n0; const float* g; const float* rsb; int bc0;
  DI void tr(const f32x4& a0, const f32x4& a1, int rl, int col, int, int, f32x4& r0, f32x4& r1) const {
    const float rs = rsb[col - bc0];
    const f32x4 g0 = *(const f32x4*)(g + n0 + rl), g1 = *(const f32x4*)(g + n0 + HALF + rl);
    r0 = a0 * g0 * rs; r1 = a1 * g1 * rs; }
  DI u16* out(int row, int ch) const { return xn + (long)row * DM + n0 + ch * 8; } };
DI void resid_norm_epi(WVP char* smem, AccT& acc, int bc0, const float* xin, float* xout, int n0, int pc, int pr, unsigned epoch,
                       u64* slab, const float* g, u16* xn, int mode) {
  const int t2 = get_tid(WV);
  const int wid2 = wave_of(t2), lane2 = t2 & 63, wr2 = wid2 >> 2, wc2 = wid2 & 3, fr2 = lane2 & 15, fq2 = lane2 >> 4;
  float* part = (float*)(smem + 139264);
  float* rsb = part + 512;
  float sq[2][2] = {{0.f, 0.f}, {0.f, 0.f}};
  for (int bj = 0; bj < 2; ++bj) for (int m = 0; m < 4; ++m) {
    for (int n = 0; n < 2; ++n) {
      const int rl = wr2 * 64 + m * 16 + fq2 * 4, col = bc0 + bj * HALF + wc2 * 32 + n * 16 + fr2;
      const f32x4 v0 = *(const f32x4*)(xin + (long)col * DM + n0 + rl) + acc[0][bj][m][n], v1 = *(const f32x4*)(xin + (long)col * DM + n0 + HALF + rl) + acc[1][bj][m][n];
      if (mode != 2) { *(f32x4*)(xout + (long)col * DM + n0 + rl) = v0; *(f32x4*)(xout + (long)col * DM + n0 + HALF + rl) = v1; }
      acc[0][bj][m][n] = v0; acc[1][bj][m][n] = v1;
      sq[bj][n] += v0[0] * v0[0] + v0[1] * v0[1] + v0[2] * v0[2] + v0[3] * v0[3] + v1[0] * v1[0] + v1[1] * v1[1] + v1[2] * v1[2] + v1[3] * v1[3];
    }
    if (m & 1) __builtin_amdgcn_sched_barrier(0);
  }
  for (int bj = 0; bj < 2; ++bj) for (int n = 0; n < 2; ++n) {
    float sv = sq[bj][n]; sv += shflx(sv, 16, lane2); sv += shflx(sv, 32, lane2);
    if (fq2 == 0) part[wr2 * 256 + bj * HALF + wc2 * 32 + n * 16 + fr2] = sv;
  }
  __syncthreads();
  if (t2 < 256) {
    const float tot = part[t2] + part[256 + t2];
    __hip_atomic_store((gu64*)(slab + ((size_t)(pc * 4 + pr) * 256 + t2)), ((u64)epoch << 32) | (u64)__float_as_uint(tot), __ATOMIC_RELAXED, __HIP_MEMORY_SCOPE_AGENT);
    gu64* gb = (gu64*)(slab + ((size_t)(pc * 4) * 256 + t2));
    float sum = 0.f;
    for (unsigned spins = 0;; ++spins) {
      bool ok = true; sum = 0.f;
#pragma unroll
      for (int q = 0; q < 4; ++q) { const u64 x = __hip_atomic_load(gb + q * 256, __ATOMIC_RELAXED, __HIP_MEMORY_SCOPE_AGENT); ok &= (unsigned)(x >> 32) == epoch; sum += __uint_as_float((unsigned)x); }
      if (__all(ok) || spins > (1u << 22)) break;
      __builtin_amdgcn_s_sleep(1);
    }
    rsb[t2] = rsqrtf(sum * (1.f / DM) + 1e-6f);
  }
  __syncthreads();
  if (mode == 1) { EpiNormOut E{xn, n0, g, rsb, bc0}; apply_epi_staged(WV, smem, acc, bc0, E); }
  if (mode == 2) {
    for (int bj = 0; bj < 2; ++bj) for (int m = 0; m < 4; ++m) {
      for (int n = 0; n < 2; ++n) {
        const int rl = wr2 * 64 + m * 16 + fq2 * 4, tc = bj * HALF + wc2 * 32 + n * 16 + fr2;
        const float rs = rsb[tc];
        const f32x4 g0 = *(const f32x4*)(g + n0 + rl), g1 = *(const f32x4*)(g + n0 + HALF + rl);
        *(f32x4*)(xout + (long)(bc0 + tc) * DM + n0 + rl) = acc[0][bj][m][n] * g0 * rs;
        *(f32x4*)(xout + (long)(bc0 + tc) * DM + n0 + HALF + rl) = acc[1][bj][m][n] * g1 * rs;
      }
      if (m & 1) __builtin_amdgcn_sched_barrier(0);
    }
  }
}

DI void phase_rmsnorm(WVP const float* __restrict__ x, const float* __restrict__ g, u16* __restrict__ o) {
  const int BID = get_bid(), GRD = get_grid();
  const int tid = get_tid(WV), wave = wave_of(tid), lane = tid & 63;
  f32x4 gv[4];
  for (int i = 0; i < 4; ++i) gv[i] = *(const f32x4*)(g + i * 256 + lane * 4);
  for (int row = BID * 8 + wave; row < TOK; row += GRD * 8) {
    f32x4 v[4]; float ss = 0.f;
    for (int i = 0; i < 4; ++i) { v[i] = *(const f32x4*)(x + (long)row * DM + i * 256 + lane * 4); ss += v[i][0] * v[i][0] + v[i][1] * v[i][1] + v[i][2] * v[i][2] + v[i][3] * v[i][3]; }
    for (int d = 32; d >= 1; d >>= 1) ss += shflx(ss, d, lane);
    float rs = rsqrtf(ss * (1.f / DM) + 1e-6f);
    for (int i = 0; i < 4; ++i) store4bf(o + (long)row * DM + i * 256 + lane * 4, v[i] * rs * gv[i]);
  }
}
DI void phase_final_norm(WVP float* __restrict__ x, const float* __restrict__ g) {
  const int BID = get_bid(), GRD = get_grid();
  const int tid = get_tid(WV), wave = wave_of(tid), lane = tid & 63;
  f32x4 gv[4];
  for (int i = 0; i < 4; ++i) gv[i] = *(const f32x4*)(g + i * 256 + lane * 4);
  for (int row = BID * 8 + wave; row < TOK; row += GRD * 8) {
    f32x4 v[4]; float ss = 0.f;
    for (int i = 0; i < 4; ++i) { v[i] = *(const f32x4*)(x + (long)row * DM + i * 256 + lane * 4); ss += v[i][0] * v[i][0] + v[i][1] * v[i][1] + v[i][2] * v[i][2] + v[i][3] * v[i][3]; }
    for (int d = 32; d >= 1; d >>= 1) ss += shflx(ss, d, lane);
    float rs = rsqrtf(ss * (1.f / DM) + 1e-6f);
    for (int i = 0; i < 4; ++i) *(f32x4*)(x + (long)row * DM + i * 256 + lane * 4) = v[i] * rs * gv[i];
  }
}

DI void transpose_tile(WVP float* sm, const float* __restrict__ src, int lds_, u16* __restrict__ dst, int ldd, int k0, int n0) {
  const int tid = get_tid(WV);
  constexpr int P = 257;
  f32x4 v[8];
  const int rb = tid >> 6, c4 = (tid & 63) * 4;
#pragma unroll
  for (int i = 0; i < 8; ++i) v[i] = *(const f32x4*)(src + (long)(k0 + rb + 8 * i) * lds_ + n0 + c4);
  __syncthreads();
#pragma unroll
  for (int i = 0; i < 8; ++i) for (int j = 0; j < 4; ++j) sm[(rb + 8 * i) * P + c4 + j] = v[i][j];
  __syncthreads();
#pragma unroll
  for (int i = 0; i < 4; ++i) {
    const int c = tid + NTHR * i, n = c >> 3, k8 = (c & 7) * 8;
    u32x4 o;
    o[0] = pack2(sm[(k8 + 0) * P + n], sm[(k8 + 1) * P + n]); o[1] = pack2(sm[(k8 + 2) * P + n], sm[(k8 + 3) * P + n]);
    o[2] = pack2(sm[(k8 + 4) * P + n], sm[(k8 + 5) * P + n]); o[3] = pack2(sm[(k8 + 6) * P + n], sm[(k8 + 7) * P + n]);
    *(u32x4*)(dst + (long)(n0 + n) * ldd + k0 + k8) = o;
  }
}
DI void phase_wprep(WVP CP pp, int l, char* smem, int mask) {
  const int BID = get_bid(), GRD = get_grid();
  char* ws = pp->ws;
  float* sm = (float*)smem;
  const float* w_in = pp->in[2] + (size_t)l * DM * INW;
  const float* w_gate = pp->in[16] + (size_t)l * 4 * DM * DM;
  const float* w_branch = pp->in[15] + (size_t)l * 1792 * DM;
  const float* w_out = pp->in[17] + (size_t)l * DM * DM;
  const float* w_up = pp->in[19] + (size_t)l * DM * 2 * FFN;
  const float* w_down = pp->in[20] + (size_t)l * FFN * DM;
  const float* w_glu = pp->in[14] + (size_t)l * 512 * 1024;
  u16* WB = (u16*)(ws + WS_WB);
  constexpr int NJ = 12;
  const float* src[NJ] = {w_in, w_gate, w_gate + DM * DM, w_gate + 2 * DM * DM, w_gate + 3 * DM * DM,
                          w_branch + 512 * DM, w_branch + 768 * DM, w_branch + 1280 * DM, w_out, w_up, w_down, w_glu};
  const int lds_[NJ] = {INW, DM, DM, DM, DM, DM, DM, DM, DM, 2 * FFN, DM, 1024};
  const int Kd[NJ] = {DM, DM, DM, DM, DM, 256, 512, 512, DM, DM, FFN, 512};
  const int Nd[NJ] = {INW, DM, DM, DM, DM, DM, DM, DM, DM, 2 * FFN, DM, 1024};
  u16* dst[NJ] = {(u16*)(ws + WS_WIN), (u16*)(ws + WS_WG), (u16*)(ws + WS_WG) + DM * DM, (u16*)(ws + WS_WG) + 2 * DM * DM, (u16*)(ws + WS_WG) + 3 * DM * DM,
                  WB + DM * 512, WB + DM * 768, WB + DM * 1280, (u16*)(ws + WS_WO), (u16*)(ws + WS_WUP), (u16*)(ws + WS_WDN), (u16*)(ws + WS_WGLU)};
  int base = 0;
#pragma unroll
  for (int j = 0; j < NJ; ++j) {
    if (!((mask >> j) & 1)) continue;
    int nk = Kd[j] / 64, nn = Nd[j] / 256, cnt = nk * nn;
    int first = (BID - base % GRD + GRD) % GRD;
    for (int i = first; i < cnt; i += GRD) transpose_tile(WV, sm, src[j], lds_[j], dst[j], Kd[j], (i / nn) * 64, (i % nn) * 256);
    base += cnt;
  }
  const float* pool_w = pp->in[3] + (size_t)l * 4 * 128 * 128;
  const float* pool_s = pp->in[4] + (size_t)l * 512;
  for (int it = GRD - 1 - BID; it < (((mask >> 12) & 1) ? 16 * 16 : 0); it += GRD) {
    const int k0 = (it >> 4) * 32, n0 = (it & 15) * 64;
    const int tid = get_tid(WV);
    const int n = n0 + (tid & 63), kb = k0 + (tid >> 6) * 4, g = kb >> 7;
    float accv[4] = {0, 0, 0, 0};
    const float* pw = pool_w + (size_t)(g * 128 + (kb & 127)) * 128;
#pragma unroll 2
    for (int d = 0; d < 128; d += 4) {
      const f32x4 ps = *(const f32x4*)(pool_s + g * 128 + d);
      float wv[4];
      for (int q = 0; q < 4; ++q) wv[q] = ps[q] * w_branch[(long)(g * 128 + d + q) * DM + n];
      for (int jj = 0; jj < 4; ++jj) {
        const f32x4 p4 = *(const f32x4*)(pw + jj * 128 + d);
        accv[jj] += p4[0] * wv[0] + p4[1] * wv[1] + p4[2] * wv[2] + p4[3] * wv[3];
      }
    }
    uint2 o; o.x = pack2(accv[0], accv[1]); o.y = pack2(accv[2], accv[3]);
    *(uint2*)(WB + (long)n * 512 + kb) = o;
  }
}

DI void mix_pool(WVP const u16* __restrict__ proj, u16* __restrict__ pb) {
  const int BID = get_bid(), GRD = get_grid();
  const int tid = get_tid(WV);
  for (int idx = BID * NTHR + tid; idx < (TOK / 16) * 64; idx += GRD * NTHR) {
    const int cc = idx & 63, t0 = (idx >> 6) * 16, gi = cc >> 4, w = 2 << gi, s0 = t0 & (SEQ - 1);
    const u16* base = proj + (long)t0 * INW + cc * 8;
    float a[8] = {0, 0, 0, 0, 0, 0, 0, 0};
    for (int i = 1; i < w; ++i) {
      if (s0 - i >= 0) {
        const u32x4 v = *(const u32x4*)(base - (long)i * INW);
        a[0] += bflo(v[0]); a[1] += bfhi(v[0]); a[2] += bflo(v[1]); a[3] += bfhi(v[1]); a[4] += bflo(v[2]); a[5] += bfhi(v[2]); a[6] += bflo(v[3]); a[7] += bfhi(v[3]);
      }
    }
#pragma unroll 4
    for (int k = 0; k < 16; ++k) {
      const int s = s0 + k;
      const u32x4 v = *(const u32x4*)(base + (long)k * INW);
      float u[8] = {bflo(v[0]), bfhi(v[0]), bflo(v[1]), bfhi(v[1]), bflo(v[2]), bfhi(v[2]), bflo(v[3]), bfhi(v[3])};
      for (int q = 0; q < 8; ++q) a[q] += u[q];
      const float ic = 1.f / (float)min(w, s + 1);
      u32x4 o;
      o[0] = pack2(a[0] * ic - u[0], a[1] * ic - u[1]); o[1] = pack2(a[2] * ic - u[2], a[3] * ic - u[3]);
      o[2] = pack2(a[4] * ic - u[4], a[5] * ic - u[5]); o[3] = pack2(a[6] * ic - u[6], a[7] * ic - u[7]);
      *(u32x4*)(pb + (long)(t0 + k) * 512 + cc * 8) = o;
      if (s - w + 1 >= 0) {
        const u32x4 x = *(const u32x4*)(base + (long)(k - w + 1) * INW);
        a[0] -= bflo(x[0]); a[1] -= bfhi(x[0]); a[2] -= bflo(x[1]); a[3] -= bfhi(x[1]); a[4] -= bflo(x[2]); a[5] -= bfhi(x[2]); a[6] -= bflo(x[3]); a[7] -= bfhi(x[3]);
      }
    }
  }
}

DI int t5_bucket(int dist) {
  if (dist < 16) return dist;
  const int thr[15] = {22, 30, 40, 54, 73, 99, 134, 182, 246, 332, 450, 609, 825, 1117, 1513};
  int b = 16;
#pragma unroll
  for (int k = 0; k < 15; ++k) b += (dist >= thr[k]) ? 1 : 0;
  return b;
}
DI void mix_dil(WVP u16* __restrict__ proj, float* __restrict__ lse, const float* __restrict__ rel_bias, char* smem) {
  const int BID = get_bid(), GRD = get_grid();
  const int tid = get_tid(WV), wave = wave_of(tid), lane = tid & 63, h = lane >> 5, l31 = lane & 31;
  float* btab = (float*)smem;
  char* vbuf = smem + 12 * 132 * 4 + wave * 4608;
  __syncthreads();
  for (int i = tid; i < 12 * 129; i += NTHR) {
    int H = i / 129, ds = i % 129, g = H >> 2; int dil = g == 0 ? 1 : (g == 1 ? 4 : 16);
    btab[H * 132 + ds] = rel_bias[t5_bucket(ds * dil) * 12 + H] * 1.44269504089f;
  }
  __syncthreads();
  const float sc = 1.44269504089f * 0.125f;
  const int i16 = lane & 15, tq = i16 >> 2, tp = i16 & 3, blk = (lane >> 4) & 1;
#define DIL_DECODE(u_, tb_, q0_, H_, dil_, j0_) \
    const int v_ = (u_) & 127, hh_ = ((u_) >> 7) & 3, g_ = ((u_) >> 9) % 3, b_ = (u_) / (512 * 3); \
    const int dsh_ = g_ * 2; dil_ = 1 << dsh_; const int nq_ = (SEQ >> dsh_) >> 5; \
    const int r_ = v_ / nq_; q0_ = (v_ % nq_) * 32; H_ = g_ * 4 + hh_; tb_ = (long)b_ * SEQ + r_; j0_ = q0_ >= 128 ? 0 : (128 - q0_) >> 5;
  bf16x8 bq_n[4], ak_n[4]; u32x4 vv_n[4];
  const int u_first = BID * 8 + wave, u_step = GRD * 8, u_end = BATCH * 3 * 4 * 128;
  if (u_first < u_end) {
    long tb; int q0, H, dil, j0; DIL_DECODE(u_first, tb, q0, H, dil, j0)
    const u16* qp = proj + (tb + (long)(q0 + l31) * dil) * INW + O1 + H * 64;
    for (int s = 0; s < 4; ++s) bq_n[s] = *(const bf16x8*)(qp + 16 * s + 8 * h);
    const u16* kp = proj + (tb + (long)(q0 - 128 + 32 * j0 + l31) * dil) * INW + O1 + 768 + H * 64;
    for (int s = 0; s < 4; ++s) ak_n[s] = *(const bf16x8*)(kp + 16 * s + 8 * h);
    for (int c = 0; c < 4; ++c) vv_n[c] = *(const u32x4*)(kp + 768 + h * 32 + c * 8);
  }
#pragma nounroll
  for (int u = u_first; u < u_end; u += u_step) {
    long tbase; int q0, H, dil, j0; DIL_DECODE(u, tbase, q0, H, dil, j0)
    u16* qp = proj + (tbase + (long)(q0 + l31) * dil) * INW + O1 + H * 64;
    bf16x8 bq[4];
    for (int s = 0; s < 4; ++s) bq[s] = bq_n[s];
    f32x16 O[2]; for (int e = 0; e < 2; ++e) for (int i = 0; i < 16; ++i) O[e][i] = 0.f;
    float mrun = -1e30f, lsum = 0.f;
    const float* bt = btab + H * 132;
    const u16* kbase_ = proj + tbase * INW + O1 + 768 + H * 64;
    f32x16 sacc; for (int i = 0; i < 16; ++i) sacc[i] = 0.f;
    for (int s = 0; s < 4; ++s) sacc = MFMA32(ak_n[s], bq[s], sacc);
    u32x4 vv[4];
    for (int c = 0; c < 4; ++c) vv[c] = vv_n[c];
    if (j0 + 1 < 5) {
      const u16* kp = kbase_ + (long)(q0 - 128 + 32 * (j0 + 1) + l31) * dil * INW;
      for (int s = 0; s < 4; ++s) ak_n[s] = *(const bf16x8*)(kp + 16 * s + 8 * h);
      for (int c = 0; c < 4; ++c) vv_n[c] = *(const u32x4*)(kp + 768 + h * 32 + c * 8);
    }
#pragma nounroll
    for (int j = j0; j < 5; ++j) {
      const int kb = q0 - 128 + 32 * j;
      for (int c = 0; c < 4; ++c) *(u32x4*)(vbuf + l31 * 144 + h * 64 + c * 16) = vv[c];
      f32x16 snx; for (int i = 0; i < 16; ++i) snx[i] = 0.f;
      if (j + 1 < 5) {
        for (int s = 0; s < 4; ++s) snx = MFMA32(ak_n[s], bq[s], snx);
        for (int c = 0; c < 4; ++c) vv[c] = vv_n[c];
        if (j + 2 < 5) {
          const u16* kp = kbase_ + (long)(kb + 64 + l31) * dil * INW;
          for (int s = 0; s < 4; ++s) ak_n[s] = *(const bf16x8*)(kp + 16 * s + 8 * h);
          for (int c = 0; c < 4; ++c) vv_n[c] = *(const u32x4*)(kp + 768 + h * 32 + c * 8);
        }
      }
      if (j == 4 && u + u_step < u_end) {
        long tb2; int q02, H2, dil2, j02; DIL_DECODE(u + u_step, tb2, q02, H2, dil2, j02)
        const u16* qp2 = proj + (tb2 + (long)(q02 + l31) * dil2) * INW + O1 + H2 * 64;
        for (int s = 0; s < 4; ++s) bq_n[s] = *(const bf16x8*)(qp2 + 16 * s + 8 * h);
        const u16* kp = proj + (tb2 + (long)(q02 - 128 + 32 * j02 + l31) * dil2) * INW + O1 + 768 + H2 * 64;
        for (int s = 0; s < 4; ++s) ak_n[s] = *(const bf16x8*)(kp + 16 * s + 8 * h);
        for (int c = 0; c < 4; ++c) vv_n[c] = *(const u32x4*)(kp + 768 + h * 32 + c * 8);
      }
      float mx = -1e30f;
      for (int i = 0; i < 16; ++i) {
        int dist = (q0 + l31) - (kb + crow(i, h));
        bool ok = (dist >= 0) && (dist <= 128);
        int di = min(max(dist, 0), 128);
        float s2 = sacc[i] * sc + bt[di];
        s2 = ok ? s2 : -1e30f;
        sacc[i] = s2; mx = fmaxf(mx, s2);
      }
      mx = fmaxf(mx, shflx(mx, 32, lane));
      float mnew = fmaxf(mrun, mx);
      float alpha = fexp2(mrun - mnew);
      float ps = 0.f;
      for (int i = 0; i < 16; ++i) { float pv = sacc[i] > -1e29f ? fexp2(sacc[i] - mnew) : 0.f; sacc[i] = pv; ps += pv; }
      lsum = lsum * alpha + ps; mrun = mnew;
      for (int e = 0; e < 2; ++e) for (int i = 0; i < 16; ++i) O[e][i] *= alpha;
      __builtin_amdgcn_wave_barrier();
      for (int s = 0; s < 2; ++s) {
        bf16x8 pf = packP(sacc, s);
        for (int e = 0; e < 2; ++e) {
          s16x4 lo = tr_read(vbuf + (16 * s + 4 * h + tq) * 144 + e * 64 + 32 * blk + 8 * tp);
          s16x4 hi = tr_read(vbuf + (16 * s + 8 + 4 * h + tq) * 144 + e * 64 + 32 * blk + 8 * tp);
          bf16x8 av = __builtin_shufflevector(lo, hi, 0, 1, 2, 3, 4, 5, 6, 7);
          O[e] = MFMA32(av, pf, O[e]);
        }
      }
      __builtin_amdgcn_wave_barrier();
      sacc = snx;
    }
    float ltot = lsum + shflx(lsum, 32, lane);
    float inv = 1.f / ltot;
    for (int e = 0; e < 2; ++e) for (int gq = 0; gq < 4; ++gq) {
      f32x4 o4 = {O[e][4 * gq] * inv, O[e][4 * gq + 1] * inv, O[e][4 * gq + 2] * inv, O[e][4 * gq + 3] * inv};
      store4bf(qp + 32 * e + 8 * gq + 4 * h, o4);
    }
    if (h == 0) lse[(tbase + (long)(q0 + l31) * dil) * 12 + H] = (mrun + flog2(ltot)) * 0.6931471805599453f;
  }
}

DI void mix_dil_merge(WVP u16* __restrict__ proj, const float* __restrict__ lse) {
  const int BID = get_bid(), GRD = get_grid();
  const int tid = get_tid(WV);
  for (long idx = (long)BID * NTHR + tid; idx < (long)TOK * 32; idx += (long)GRD * NTHR) {
    int c8 = (int)(idx & 7), j = (int)(idx >> 3) & 3; long tok = idx >> 5;
    float l0 = lse[tok * 12 + j], l1 = lse[tok * 12 + 4 + j], l2 = lse[tok * 12 + 8 + j];
    float m = fmaxf(l0, fmaxf(l1, l2));
    float e0 = __expf(l0 - m), e1 = __expf(l1 - m), e2 = __expf(l2 - m), inv = 1.f / (e0 + e1 + e2);
    e0 *= inv; e1 *= inv; e2 *= inv;
    u16* base = proj + tok * INW + O1 + j * 64 + c8 * 8;
    uint4 a = *(const uint4*)base, b = *(const uint4*)(base + 256), c = *(const uint4*)(base + 512), o;
    o.x = pack2(e0 * bflo(a.x) + e1 * bflo(b.x) + e2 * bflo(c.x), e0 * bfhi(a.x) + e1 * bfhi(b.x) + e2 * bfhi(c.x));
    o.y = pack2(e0 * bflo(a.y) + e1 * bflo(b.y) + e2 * bflo(c.y), e0 * bfhi(a.y) + e1 * bfhi(b.y) + e2 * bfhi(c.y));
    o.z = pack2(e0 * bflo(a.z) + e1 * bflo(b.z) + e2 * bflo(c.z), e0 * bfhi(a.z) + e1 * bfhi(b.z) + e2 * bfhi(c.z));
    o.w = pack2(e0 * bflo(a.w) + e1 * bflo(b.w) + e2 * bflo(c.w), e0 * bfhi(a.w) + e1 * bfhi(b.w) + e2 * bfhi(c.w));
    *(uint4*)base = o;
  }
}

DI void mix_sb(WVP u16* __restrict__ proj, char* smem) {
  const int BID = get_bid(), GRD = get_grid();
  const int tid = get_tid(WV), wave = wave_of(tid), lane = tid & 63, h = lane >> 5, l31 = lane & 31;
  constexpr int RS = 272, TB = 32 * RS;
  char* kbuf = smem; char* vbuf = smem + 2 * TB; int* flags = (int*)(smem + 4 * TB);
  const int i16 = lane & 15, tq = i16 >> 2, tp = i16 & 3, blk = (lane >> 4) & 1;
  const float sc = 1.44269504089f * 0.08838834764831845f;
  const float RTH = -60.f;
  const int lrow = tid >> 4, lch = tid & 15;
  for (int it = BID; it < BATCH * 4 * 16; it += GRD) {
    int qb = 15 - (it & 15), hh = (it >> 4) & 3, b = it >> 6;
    int Q0 = qb * 256;
    u16* base = proj + (long)b * SEQ * INW + O2 + hh * 128;
    u16* qp = base + (long)(Q0 + 32 * wave + l31) * INW;
    bf16x8 bq[8];
    for (int s = 0; s < 8; ++s) bq[s] = *(const bf16x8*)(qp + 16 * s + 8 * h);
    f32x16 O[4]; for (int e = 0; e < 4; ++e) for (int i = 0; i < 16; ++i) O[e][i] = 0.f;
    float R = 0.f;
    const int kt_hi = Q0 / 32 + 7, kt_diag = Q0 / 32 + wave;
    __syncthreads();
    if (tid < 16) flags[tid] = 0;
    {
      const u16* kp = base + 512 + (long)(kt_hi * 32 + lrow) * INW + lch * 8;
      uint4 kv = *(const uint4*)kp, vv = *(const uint4*)(kp + 512);
      *(uint4*)(kbuf + lrow * RS + lch * 16) = kv; *(uint4*)(vbuf + lrow * RS + lch * 16) = vv;
    }
    __syncthreads();
    int cur = 0, iter = 0;
    for (int kt = kt_hi; kt >= 0; --kt, ++iter) {
      uint4 kv, vv;
      const bool more = kt > 0;
      if (more) { const u16* kp = base + 512 + (long)((kt - 1) * 32 + lrow) * INW + lch * 8; kv = *(const uint4*)kp; vv = *(const uint4*)(kp + 512); }
      bool wdone = false;
      if (kt <= kt_diag) {
        const char* kb_ = kbuf + cur * TB; const char* vb_ = vbuf + cur * TB;
        f32x16 sacc; for (int i = 0; i < 16; ++i) sacc[i] = 0.f;
        for (int s = 0; s < 8; ++s) { bf16x8 ak = *(const bf16x8*)(kb_ + l31 * RS + 32 * s + 16 * h); sacc = MFMA32(ak, bq[s], sacc); }
        const bool diag = (kt == kt_diag);
        float ls[16];
        for (int i = 0; i < 16; ++i) {
          float z2 = sacc[i] * sc;
          float sp = fmaxf(z2, 0.f) + flog2(1.f + fexp2(-fabsf(z2)));
          bool ok = !diag || (crow(i, h) < l31);
          ls[i] = ok ? -sp : 0.f;
          sacc[i] = ok ? z2 : -1e30f;
        }
        float G[4], Gp[4], tot[4];
        for (int g = 0; g < 4; ++g) G[g] = (ls[4 * g] + ls[4 * g + 1]) + (ls[4 * g + 2] + ls[4 * g + 3]);
        for (int g = 0; g < 4; ++g) { Gp[g] = shflx(G[g], 32, lane); tot[g] = G[g] + Gp[g]; }
        float after = 0.f;
        for (int g = 3; g >= 0; --g) {
          float tail = R + after + (h == 0 ? Gp[g] : 0.f);
          float c3 = tail + ls[4 * g + 3], c2 = c3 + ls[4 * g + 2], c1 = c2 + ls[4 * g + 1], c0 = c1 + ls[4 * g];
          sacc[4 * g + 3] = fexp2(sacc[4 * g + 3] + c3); sacc[4 * g + 2] = fexp2(sacc[4 * g + 2] + c2);
          sacc[4 * g + 1] = fexp2(sacc[4 * g + 1] + c1); sacc[4 * g] = fexp2(sacc[4 * g] + c0);
          after += tot[g];
        }
        R += after;
        for (int s = 0; s < 2; ++s) {
          bf16x8 pf = packP(sacc, s);
          for (int e = 0; e < 4; ++e) {
            s16x4 lo = tr_read(vb_ + (16 * s + 4 * h + tq) * RS + e * 64 + 32 * blk + 8 * tp);
            s16x4 hi = tr_read(vb_ + (16 * s + 8 + 4 * h + tq) * RS + e * 64 + 32 * blk + 8 * tp);
            bf16x8 av = __builtin_shufflevector(lo, hi, 0, 1, 2, 3, 4, 5, 6, 7);
            O[e] = MFMA32(av, pf, O[e]);
          }
        }
        wdone = __all(R < RTH);
      }
      if (lane == 0) flags[(iter & 1) * 8 + wave] = wdone ? 1 : 0;
      if (more) { *(uint4*)(kbuf + (cur ^ 1) * TB + lrow * RS + lch * 16) = kv; *(uint4*)(vbuf + (cur ^ 1) * TB + lrow * RS + lch * 16) = vv; }
      __syncthreads();
      cur ^= 1;
      int nd = 0;
      for (int w2 = 0; w2 < 8; ++w2) nd += flags[(iter & 1) * 8 + w2];
      if (nd == 8) break;
    }
    for (int e = 0; e < 4; ++e) for (int gq = 0; gq < 4; ++gq) {
      f32x4 o4 = {O[e][4 * gq], O[e][4 * gq + 1], O[e][4 * gq + 2], O[e][4 * gq + 3]};
      store4bf(qp + 32 * e + 8 * gq + 4 * h, o4);
    }
  }
}

DI void mix_s5(WVP CP pp, int l, u16* __restrict__ proj, char* smem) {
  const int BID = get_bid(), GRD = get_grid();
  const int tid = get_tid(WV), wave = wave_of(tid), lane = tid & 63, h = lane >> 5, l31 = lane & 31;
  constexpr int RSF = 132;
  float* buf = (float*)smem + wave * 32 * RSF;
  float* hend = (float*)(smem + 8 * 32 * RSF * 4);
  for (int it = BID; it < BATCH * 32; it += GRD) {
    const int g = it & 31, b = it >> 5;
    const float* a_re = pp->in[6] + ((size_t)l * 32 + g) * 64;
    const float* a_im = pp->in[7] + ((size_t)l * 32 + g) * 64;
    const float dt = __expf(pp->in[8][l * 32 + g]);
    const float* b_re = pp->in[9] + ((size_t)l * 32 + g) * 64 * 16;
    const float* b_im = pp->in[10] + ((size_t)l * 32 + g) * 64 * 16;
    const float* c_re = pp->in[11] + ((size_t)l * 32 + g) * 16 * 64;
    const float* c_im = pp->in[12] + ((size_t)l * 32 + g) * 16 * 64;
    const float* dsk = pp->in[13] + (size_t)l * 512 + g * 16;
    float lr, li;
    { float ar = a_re[lane], ai = a_im[lane]; float mg = expf(ar * dt); float sn, cs; sincosf(ai * dt, &sn, &cs); lr = mg * cs; li = mg * sn; }
    bf16x8 bfrag[4];
    float lam_r[2], lam_i[2];
    for (int half = 0; half < 2; ++half) {
      int ps = 32 * half + l31;
      float ar = a_re[ps], ai = a_im[ps]; float mg = expf(ar * dt); float sn, cs; sincosf(ai * dt, &sn, &cs);
      lam_r[half] = mg * cs; lam_i[half] = mg * sn;
      float xr = mg * cs - 1.f, xi = mg * sn, den = 1.f / (ar * ar + ai * ai);
      float cr = (xr * ar + xi * ai) * den, ci = (xi * ar - xr * ai) * den;
      float vr[8], vi[8];
      for (int j = 0; j < 8; ++j) { float br = b_re[ps * 16 + 8 * h + j], bi = b_im[ps * 16 + 8 * h + j]; vr[j] = cr * br - ci * bi; vi[j] = cr * bi + ci * br; }
      uint4 a = {pack2(vr[0], vr[1]), pack2(vr[2], vr[3]), pack2(vr[4], vr[5]), pack2(vr[6], vr[7])};
      uint4 c = {pack2(vi[0], vi[1]), pack2(vi[2], vi[3]), pack2(vi[4], vi[5]), pack2(vi[6], vi[7])};
      bfrag[half] = __builtin_bit_cast(bf16x8, a); bfrag[2 + half] = __builtin_bit_cast(bf16x8, c);
    }
    bf16x8 cfrag[4];
    { int c = lane & 15, kq = lane >> 4;
      for (int s = 0; s < 4; ++s) {
        float v[8];
        for (int j = 0; j < 8; ++j) { int k = 32 * s + 8 * kq + j; v[j] = k < 64 ? c_re[c * 64 + k] : -c_im[c * 64 + k - 64]; }
        uint4 a = {pack2(v[0], v[1]), pack2(v[2], v[3]), pack2(v[4], v[5]), pack2(v[6], v[7])};
        cfrag[s] = __builtin_bit_cast(bf16x8, a);
      } }
    const float dskip = dsk[lane & 15];
    u16* ub = proj + ((long)b * SEQ + wave * 512) * INW + O3 + g * 16;
    float hr = 0.f, hi = 0.f;
    __syncthreads();
    if (wave < 7) {
      float Hr[2] = {0.f, 0.f}, Hi[2] = {0.f, 0.f};
      float wre[2][16], wim[2][16], l32r[2], l32i[2];
      for (int half = 0; half < 2; ++half) {
        const float ar = lam_r[half], ai = lam_i[half];
        const float l2r = ar * ar - ai * ai, l2i = 2.f * ar * ai;
        const float l4r = l2r * l2r - l2i * l2i, l4i = 2.f * l2r * l2i;
        const float l5r = l4r * ar - l4i * ai, l5i = l4r * ai + l4i * ar;
        const float l8r = l4r * l4r - l4i * l4i, l8i = 2.f * l4r * l4i;
        const float l16r = l8r * l8r - l8i * l8i, l16i = 2.f * l8r * l8i;
        l32r[half] = l16r * l16r - l16i * l16i; l32i[half] = 2.f * l16r * l16i;
        float cr = h ? 1.f : l4r, ci = h ? 0.f : l4i;
#pragma unroll
        for (int i = 15; i >= 0; --i) {
          wre[half][i] = cr; wim[half][i] = ci;
          const float mr = (i & 3) ? ar : l5r, mi = (i & 3) ? ai : l5i;
          const float nr = cr * mr - ci * mi, ni = cr * mi + ci * mr; cr = nr; ci = ni;
        }
      }
      bf16x8 au_n = *(const bf16x8*)(ub + (long)l31 * INW + 8 * h);
      f32x16 z; for (int i = 0; i < 16; ++i) z[i] = 0.f;
#pragma nounroll
      for (int ch = 0; ch < 16; ++ch) {
        const bf16x8 au = au_n;
        if (ch + 1 < 16) au_n = *(const bf16x8*)(ub + (long)((ch + 1) * 32 + l31) * INW + 8 * h);
#pragma unroll
        for (int half = 0; half < 2; ++half) {
          const f32x16 bre = MFMA32(au, bfrag[half], z), bim = MFMA32(au, bfrag[2 + half], z);
          float sr = 0.f, si = 0.f;
#pragma unroll
          for (int i = 0; i < 16; ++i) { sr += wre[half][i] * bre[i] - wim[half][i] * bim[i]; si += wre[half][i] * bim[i] + wim[half][i] * bre[i]; }
          sr += shflx(sr, 32, lane); si += shflx(si, 32, lane);
          const float nr = l32r[half] * Hr[half] - l32i[half] * Hi[half] + sr, ni = l32r[half] * Hi[half] + l32i[half] * Hr[half] + si;
          Hr[half] = nr; Hi[half] = ni;
        }
      }
      if (h == 0) {
        hend[wave * 128 + l31] = Hr[0]; hend[wave * 128 + 64 + l31] = Hi[0];
        hend[wave * 128 + 32 + l31] = Hr[1]; hend[wave * 128 + 96 + l31] = Hi[1];
      }
    }
    __syncthreads();
    for (int pass = 1; pass < 2; ++pass) {
      if (pass == 1) {
        float pr_ = lr, pi_ = li;
        for (int k = 0; k < 9; ++k) { float nr = pr_ * pr_ - pi_ * pi_, ni = 2.f * pr_ * pi_; pr_ = nr; pi_ = ni; }
        hr = 0.f; hi = 0.f;
        for (int v = 0; v < wave; ++v) { float er = hend[v * 128 + lane], ei = hend[v * 128 + 64 + lane]; float nr = pr_ * hr - pi_ * hi + er, ni = pr_ * hi + pi_ * hr + ei; hr = nr; hi = ni; }
      }
      if (pass == 1 || wave < 7) {
        const int cch = lane & 15, kqq = lane >> 4;
        bf16x8 au_n = *(const bf16x8*)(ub + (long)l31 * INW + 8 * h);
        u16 us_n[8] = {0, 0, 0, 0, 0, 0, 0, 0};
        if (pass == 1) for (int q = 0; q < 8; ++q) us_n[q] = ub[(long)(16 * (q >> 2) + 4 * kqq + (q & 3)) * INW + cch];
#pragma nounroll
        for (int ch = 0; ch < 16; ++ch) {
          u16* up = ub + (long)(ch * 32) * INW;
          const bf16x8 au = au_n;
          u16 us[8];
          for (int q = 0; q < 8; ++q) us[q] = us_n[q];
          if (ch + 1 < 16) {
            const u16* un = up + (long)32 * INW;
            au_n = *(const bf16x8*)(un + (long)l31 * INW + 8 * h);
            if (pass == 1) for (int q = 0; q < 8; ++q) us_n[q] = un[(long)(16 * (q >> 2) + 4 * kqq + (q & 3)) * INW + cch];
          }
          f32x16 z; for (int i = 0; i < 16; ++i) z[i] = 0.f;
          for (int nt = 0; nt < 4; ++nt) {
            f32x16 bu = MFMA32(au, bfrag[nt], z);
            for (int i = 0; i < 16; ++i) buf[crow(i, h) * RSF + (nt >> 1) * 64 + (nt & 1) * 32 + l31] = bu[i];
          }
          __builtin_amdgcn_wave_barrier();
          {
            float sre[32], sim[32];
#pragma unroll
            for (int t = 0; t < 32; ++t) { sre[t] = buf[t * RSF + lane]; sim[t] = buf[t * RSF + 64 + lane]; }
#pragma unroll
            for (int t = 0; t < 32; ++t) {
              float nr = lr * hr - li * hi + sre[t], ni = lr * hi + li * hr + sim[t]; hr = nr; hi = ni; sre[t] = hr; sim[t] = hi;
            }
            if (pass == 1) {
#pragma unroll
              for (int t = 0; t < 32; ++t) { buf[t * RSF + lane] = sre[t]; buf[t * RSF + 64 + lane] = sim[t]; }
            }
          }
          __builtin_amdgcn_wave_barrier();
          if (pass == 1) {
            for (int mt = 0; mt < 2; ++mt) {
              f32x4 y = {0.f, 0.f, 0.f, 0.f};
              for (int s2 = 0; s2 < 4; ++s2) {
                const float* hp = buf + (16 * mt + cch) * RSF + 32 * s2 + 8 * kqq;
                f32x4 x0 = *(const f32x4*)hp, x1 = *(const f32x4*)(hp + 4);
                uint4 a = {pack2(x0[0], x0[1]), pack2(x0[2], x0[3]), pack2(x1[0], x1[1]), pack2(x1[2], x1[3])};
                y = MFMA16(__builtin_bit_cast(bf16x8, a), cfrag[s2], y);
              }
              for (int j = 0; j < 4; ++j) {
                int t = 16 * mt + 4 * kqq + j;
                float yv = y[j] + dskip * bf2f(us[4 * mt + j]);
                up[(long)t * INW + cch] = f2bf(gelu_tanh(yv));
              }
            }
            __builtin_amdgcn_wave_barrier();
          }
        }
      }
      if (pass == 0) { hend[wave * 128 + lane] = hr; hend[wave * 128 + 64 + lane] = hi; __syncthreads(); }
    }
    __syncthreads();
  }
}


#define XB_TMO      128
#define XB_XCNT(j)  (256  + 64 * (j))
#define XB_XSUB(j)  (1280 + 64 * (j))
#define XB_XGEN(j)  (2304 + 64 * (j))
#define XB_TOP      3328
#define XB_TOPGEN   3392
#define XCD_BAR_WORDS 3456
#define XB_SPIN_CAP (1u << 22)
DI unsigned xb_ld(unsigned* p)              { return __hip_atomic_load(p, __ATOMIC_RELAXED, __HIP_MEMORY_SCOPE_AGENT); }
DI unsigned xb_add(unsigned* p, unsigned v) { return __hip_atomic_fetch_add(p, v, __ATOMIC_RELAXED, __HIP_MEMORY_SCOPE_AGENT); }
DI unsigned xb_xcc_id() { return (unsigned)__builtin_amdgcn_s_getreg((3 << 11) | 20) & 0xFu; }
#define XB_SPIN(cond, bar) do { unsigned _sp = 0; while (cond) { __builtin_amdgcn_s_sleep(1); \
    if ((++_sp & 255u) == 0u) { if (xb_ld(&(bar)[XB_TMO])) break; if (_sp > XB_SPIN_CAP) { atomicAdd(&(bar)[XB_TMO], 1u); break; } } } } while (0)
struct XcdBarrier { unsigned* bar; unsigned x; volatile LAS unsigned* st; };
DI XcdBarrier xcd_barrier_post(unsigned* bar, volatile LAS unsigned* st) {
  XcdBarrier b; b.bar = bar; b.x = xb_xcc_id(); b.st = st;
  if (threadIdx.x == 0) (void)xb_add(&bar[XB_XCNT(b.x)], 1u);
  return b;
}
DI void xcd_barrier_complete(unsigned* bar, unsigned x, unsigned& nloc, unsigned& nx) {
  const unsigned G = gridDim.x * gridDim.y * gridDim.z;
  unsigned sum, cnt, mine, sp = 0u;
  for (;;) {
    sum = 0u; cnt = 0u; mine = 0u;
#pragma unroll
    for (unsigned j = 0; j < 16; ++j) { const unsigned c = xb_ld(&bar[XB_XCNT(j)]); sum += c; cnt += (c > 0u) ? 1u : 0u; mine = (j == x) ? c : mine; }
    if (sum == G) break;
    __builtin_amdgcn_s_sleep(1);
    if ((++sp & 255u) == 0u) { if (xb_ld(&bar[XB_TMO])) break; if (sp > XB_SPIN_CAP) { atomicAdd(&bar[XB_TMO], 1u); break; } }
  }
  nloc = mine > 0u ? mine : 1u; nx = cnt > 0u ? cnt : 1u;
}
DI void xcd_barrier(const XcdBarrier& b) {
  asm volatile("s_waitcnt vmcnt(0)" ::: "memory");
  __syncthreads();
  if (threadIdx.x == 0) {
    unsigned* bar = b.bar;
    __builtin_amdgcn_s_waitcnt(0);
    unsigned nloc = b.st[0], nx = b.st[1];
    if (nloc == 0u) { xcd_barrier_complete(bar, b.x, nloc, nx); b.st[0] = nloc; b.st[1] = nx; }
    const unsigned old = xb_add(&bar[XB_XSUB(b.x)], 1u);
    const unsigned gen = old / nloc;
    if (old + 1u == (gen + 1u) * nloc) {
      __builtin_amdgcn_fence(__ATOMIC_RELEASE, "agent");
      asm volatile("s_waitcnt vmcnt(0)" ::: "memory");
      const unsigned og = xb_add(&bar[XB_TOP], 1u);
      const unsigned tg = og / nx;
      if (og + 1u == (tg + 1u) * nx) xb_add(&bar[XB_TOPGEN], 1u);
      else XB_SPIN(xb_ld(&bar[XB_TOPGEN]) == tg, bar);
      __builtin_amdgcn_fence(__ATOMIC_ACQUIRE, "agent");
      xb_add(&bar[XB_XGEN(b.x)], 1u);
      asm volatile("s_waitcnt vmcnt(0)" ::: "memory");
    } else {
      XB_SPIN(xb_ld(&bar[XB_XGEN(b.x)]) == gen, bar);
      __builtin_amdgcn_fence(__ATOMIC_ACQUIRE, "agent");
      asm volatile("s_waitcnt vmcnt(0)" ::: "memory");
    }
  }
  __syncthreads();
}

__global__ void __launch_bounds__(NTHR) mega(Params p) {
  extern __shared__ __attribute__((aligned(16))) char smem[];

  const int ph_lo = p.ph_lo, ph_hi = p.ph_hi;
  const int WV = __builtin_amdgcn_readfirstlane(threadIdx.x >> 6);
  volatile LAS unsigned* xst = (volatile LAS unsigned*)(smem + LDS_BYTES - 16);
  if (threadIdx.x == 0) { xst[0] = 0u; xst[1] = 0u; }
  __syncthreads();
  (void)xcd_barrier_post((unsigned*)(p.ws + WS_BAR), xst);
  for (int ph = ph_lo; ph < ph_hi; ++ph) {
    if (ph % PH_PER_LAYER == 6 || (ph % PH_PER_LAYER == 0 && ph > 0)) continue;
    if (ph == ph_lo + 1) cg::this_grid().sync();
    else if (ph > ph_lo) {
      CP pb_ = (CP)__builtin_amdgcn_kernarg_segment_ptr(); asm volatile("" : "+s"(pb_));
      XcdBarrier xbar; xbar.bar = (unsigned*)(pb_->ws + WS_BAR); xbar.x = xb_xcc_id(); xbar.st = (volatile LAS unsigned*)(smem + LDS_BYTES - 16);
      xcd_barrier(xbar);
    }
    const int BID = get_bid(), G = get_grid();
    CP pp = (CP)__builtin_amdgcn_kernarg_segment_ptr(); asm volatile("" : "+s"(pp));
    char* ws = pp->ws;
    u16* proj = (u16*)(ws + WS_PROJ);
    u16* xn = (u16*)(ws + WS_XN);
    u16* pb = (u16*)(ws + WS_PB);
    u16* mg = (u16*)(ws + WS_MG);
    float* lse = (float*)(ws + WS_LSE);
    u16* hbuf = proj;
    const u16* WIN = (const u16*)(ws + WS_WIN); const u16* WG = (const u16*)(ws + WS_WG); const u16* WB = (const u16*)(ws + WS_WB);
    const u16* WO = (const u16*)(ws + WS_WO); const u16* WUP = (const u16*)(ws + WS_WUP); const u16* WDN = (const u16*)(ws + WS_WDN);
    const u16* WGLU = (const u16*)(ws + WS_WGLU);
    float* xres = pp->out;
    const int l = ph / PH_PER_LAYER, k = ph % PH_PER_LAYER;
    const float* xin = (l == 0) ? pp->in[0] : xres;
    switch (k) {
      case 0: {
        if (l == 0) phase_rmsnorm(WV, xin, pp->in[1] + (size_t)l * DM, xn);
        phase_wprep(WV, pp, l, smem, 0x1fff);
      } break;
      case 1: {
        const int nR = INW / 256, nC = TOK / 256, nwg = nR * nC;
        for (int id = BID; id < nwg; id += G) {
          int pr, pc; tile_map(id, nwg, nR, nC, pr, pc);
          EpiStore2 E{proj, INW, pr * 256, pr * 256 + 128};
          gemm_tile_staged(WV, smem, WIN, DM, pr * 256, pr * 256 + 128, xn, DM, pc * 256, DM, E);
        }
      } break;
      case 2: {
        mix_s5(WV, pp, l, proj, smem);
        mix_sb(WV, proj, smem);
        mix_dil(WV, proj, lse, pp->in[5], smem);
        mix_pool(WV, proj, pb);
        if (l > 0) phase_wprep(WV, pp, l, smem, 1 << 10);
      } break;
      case 3: {
        const int nR = 4, nC = TOK / 256, nwg = nR * nC;
        for (int id = BID; id < nwg; id += G) {
          int pr, pc; tile_map(id, nwg, nR, nC, pr, pc);
          EpiGated<1> E{proj, INW, O2 + 512 + pr * 128};
          gemm_tile_staged(WV, smem, WGLU, 512, pr * 128, 512 + pr * 128, proj + O3, INW, pc * 256, 512, E);
        }
        mix_dil_merge(WV, proj, lse);
      } break;
      case 4: {
        const int nR = 4, nC = TOK / 256, nwg = nR * nC;
        for (int id = BID; id < nwg; id += G) {
          int pr, pc; tile_map(id, nwg, nR, nC, pr, pc);
#pragma nounroll
          for (int b = 0; b < 4; ++b) {
            const int q = pr * 3 + b;
            u16* sd = (b == 3) ? mg + pr * 256 : proj + (q < 8 ? 768 + 256 * q : (q < 10 ? 256 * (q - 8) : 3840 + 256 * (q - 10)));
            EpiSig E1{sd, b == 3 ? DM : INW, pc * 256};
            gemm_tile(WV, smem, WG + (size_t)b * DM * DM, DM, pr * 256, pr * 256 + 128, xn, DM, pc * 256, DM, E1);
          }
          AccT acc = {};
#pragma nounroll
          for (int b = 0; b < 4; ++b) {
            const int Kb = (b == 1) ? 256 : 512, ldy = (b == 0) ? 512 : INW;
            const u16* yb = (b == 0) ? pb : proj + (b == 1 ? O1 : (b == 2 ? O2 : O2 + 512));
            const u16* wb = WB + DM * (b == 0 ? 0 : (b == 1 ? 512 : (b == 2 ? 768 : 1280)));
            gemm_core(WV, smem, wb, Kb, pr * 256, pr * 256 + 128, yb, ldy, pc * 256, Kb, acc);
            if (b < 3) {
              const int q = pr * 3 + b, q1 = q + 1;
              u16* sc = proj + (q < 8 ? 768 + 256 * q : (q < 10 ? 256 * (q - 8) : 3840 + 256 * (q - 10)));
              u16* sn = (b == 2) ? mg + pr * 256 : proj + (q1 < 8 ? 768 + 256 * q1 : (q1 < 10 ? 256 * (q1 - 8) : 3840 + 256 * (q1 - 10)));
              EpiRescale E2{sc, INW, sn, b == 2 ? DM : INW, pc * 256};
              apply_epi(WV, acc, pc * 256, E2);
            }
          }
          EpiFinalGate E3{mg, pr * 256, pc * 256};
          apply_epi_staged(WV, smem, acc, pc * 256, E3);
        }
      } break;
      case 5: {
        const int nR = 4, nC = TOK / 256, nwg = nR * nC;
        for (int id = BID; id < nwg; id += G) {
          int pr, pc; tile_map(id, nwg, nR, nC, pr, pc);
          AccT acc = {};
          gemm_core(WV, smem, WO, DM, pr * 256, pr * 256 + 128, mg, DM, pc * 256, DM, acc);
          resid_norm_epi(WV, smem, acc, pc * 256, xin, xres, pr * 256, pc, pr, (unsigned)(ph + 1), (u64*)(ws + WS_SLAB), pp->in[18] + (size_t)l * DM, xn, 1);
        }
      } break;
      case 7: {
        const int nR = FFN / 128, nC = TOK / 256, nwg = nR * nC;
        for (int id = BID; id < nwg; id += G) {
          int pr, pc; tile_map(id, nwg, nR, nC, pr, pc);
          EpiGated<0> E{hbuf, FFN, pr * 128};
          gemm_tile_staged(WV, smem, WUP, DM, pr * 128, FFN + pr * 128, xn, DM, pc * 256, DM, E);
        }
      } break;
      case 8: {
        const int nR = 4, nC = TOK / 256, nwg = nR * nC;
        for (int id = BID; id < nwg; id += G) {
          int pr, pc; tile_map(id, nwg, nR, nC, pr, pc);
          AccT acc = {};
          gemm_core(WV, smem, WDN, FFN, pr * 256, pr * 256 + 128, hbuf, FFN, pc * 256, FFN, acc);
          resid_norm_epi(WV, smem, acc, pc * 256, xres, xres, pr * 256, pc, pr, (unsigned)(ph + 1), (u64*)(ws + WS_SLAB), (l < DEPTH - 1) ? pp->in[1] + (size_t)(l + 1) * DM : pp->in[21], xn, (l < DEPTH - 1) ? 1 : 2);
        }
        if (l < DEPTH - 1) phase_wprep(WV, pp, l + 1, smem, 0x1fff & ~(1 << 10));
      } break;
    }
  }
}

extern "C" void kernel_launch(void* const* d_in, const int* in_sizes, int n_in, void* d_out, int out_size,
                              void* d_ws, size_t ws_size, hipStream_t stream) {
  static int grid = 0;
  if (grid == 0) {
    if (n_in != 22 || ws_size < WS_END) { fprintf(stderr, "kernel_launch: unexpected n_in %d / ws_size %zu (need %zu)\n", n_in, ws_size, (size_t)WS_END); grid = -1; return; }
    int dev = 0, cus = 0, per_cu = 0;
    hipGetDevice(&dev);
    hipDeviceGetAttribute(&cus, hipDeviceAttributeMultiprocessorCount, dev);
    if (hipFuncSetAttribute((const void*)mega, hipFuncAttributeMaxDynamicSharedMemorySize, LDS_BYTES) != hipSuccess) { fprintf(stderr, "hipFuncSetAttribute failed\n"); grid = -1; return; }
    if (hipOccupancyMaxActiveBlocksPerMultiprocessor(&per_cu, (const void*)mega, NTHR, LDS_BYTES) != hipSuccess || per_cu < 1) { fprintf(stderr, "occupancy query failed (%d)\n", per_cu); per_cu = 1; (void)hipGetLastError(); }
    grid = cus * per_cu;
  }
  if (grid < 0) return;
  if (hipMemsetAsync((char*)d_ws + WS_BAR, 0, WS_END - WS_BAR, stream) != hipSuccess) { fprintf(stderr, "memset of barrier words failed\n"); return; }
  Params p{};
  for (int i = 0; i < 22; ++i) p.in[i] = (const float*)d_in[i];
  p.out = (float*)d_out; p.ws = (char*)d_ws;
#if ONE_LAUNCH
  p.ph_lo = 0; p.ph_hi = N_PHASES;
  void* args[] = {&p};
  hipError_t e = hipLaunchCooperativeKernel((const void*)mega, dim3(grid), dim3(NTHR), args, LDS_BYTES, stream);
  if (e != hipSuccess) fprintf(stderr, "cooperative launch failed: %s (grid %d)\n", hipGetErrorString(e), grid);
#else
  for (int ph = 0; ph < N_PHASES; ++ph) {
    p.ph_lo = ph; p.ph_hi = ph + 1;
    hipLaunchKernelGGL(mega, dim3(grid), dim3(NTHR), LDS_BYTES, stream, p);
  }
#endif
}
```

```cpp
#include <hip/hip_runtime.h>
#include <hip/hip_bf16.h>
#include <hip/hip_cooperative_groups.h>
#include <cstdio>
namespace cg = cooperative_groups;

#ifndef ONE_LAUNCH
#define ONE_LAUNCH 1
#endif

typedef unsigned short u16;
using bf16x8 = __attribute__((ext_vector_type(8))) short;
using s16x4  = __attribute__((ext_vector_type(4))) short;
using f32x4  = __attribute__((ext_vector_type(4))) float;
using f32x16 = __attribute__((ext_vector_type(16))) float;
using u32x4  = __attribute__((ext_vector_type(4))) unsigned;
typedef __bf16 bf2_t __attribute__((ext_vector_type(2)));
typedef float f2_t __attribute__((ext_vector_type(2)));
#define DI __device__ __forceinline__
#define LAS __attribute__((address_space(3)))

constexpr int DM = 1024, BATCH = 8, SEQ = 4096, TOK = BATCH * SEQ, DEPTH = 4;
constexpr int INW = 4864, O1 = 512, O2 = 2816, O3 = 4352;
constexpr int FFN = 2816;
constexpr int NTHR = 512;
constexpr int LDS_BYTES = 147456;
constexpr int PH_PER_LAYER = 9, N_PHASES = DEPTH * PH_PER_LAYER;

constexpr size_t WS_PROJ = 0;
constexpr size_t WS_XN   = WS_PROJ + (size_t)TOK * INW * 2;
constexpr size_t WS_PB   = WS_XN + (size_t)TOK * DM * 2;
constexpr size_t WS_MG   = WS_PB + (size_t)TOK * 512 * 2;
constexpr size_t WS_LSE  = WS_MG + (size_t)TOK * DM * 2;
constexpr size_t WS_WIN  = WS_LSE + (size_t)TOK * 12 * 4;
constexpr size_t WS_WG   = WS_WIN + (size_t)INW * DM * 2;
constexpr size_t WS_WB   = WS_WG + (size_t)4 * DM * DM * 2;
constexpr size_t WS_WO   = WS_WB + (size_t)DM * 1792 * 2;
constexpr size_t WS_WUP  = WS_WO + (size_t)DM * DM * 2;
constexpr size_t WS_WDN  = WS_WUP + (size_t)2 * FFN * DM * 2;
constexpr size_t WS_WGLU = WS_WDN + (size_t)DM * FFN * 2;
constexpr size_t WS_BAR  = WS_WGLU + (size_t)DM * 512 * 2;
constexpr size_t WS_SLAB = WS_BAR + 16384;
constexpr size_t WS_END  = WS_SLAB + (size_t)128 * 4 * 256 * 8;

struct Params {
  const float* in[22];
  float* out;
  char* ws;
  int ph_lo, ph_hi;
};
typedef const Params __attribute__((address_space(4)))* CP;

DI unsigned pack2(float a, float b) { f2_t v = {a, b}; bf2_t r = __builtin_convertvector(v, bf2_t); return __builtin_bit_cast(unsigned, r); }
DI u16 f2bf(float a) { return (u16)(pack2(a, 0.f) & 0xffffu); }
DI float bf2f(u16 v) { return __uint_as_float(((unsigned)v) << 16); }
DI float bflo(unsigned v) { return __uint_as_float(v << 16); }
DI float bfhi(unsigned v) { return __uint_as_float(v & 0xffff0000u); }
DI void store4bf(u16* p, f32x4 a) { uint2 v; v.x = pack2(a[0], a[1]); v.y = pack2(a[2], a[3]); *(uint2*)p = v; }
DI f32x4 load4bf(const u16* p) { uint2 v = *(const uint2*)p; f32x4 r = {bflo(v.x), bfhi(v.x), bflo(v.y), bfhi(v.y)}; return r; }
DI float fexp2(float x) { return __builtin_amdgcn_exp2f(x); }
DI float flog2(float x) { return __builtin_amdgcn_logf(x); }
DI float frcp(float x) { return __builtin_amdgcn_rcpf(x); }
DI float sigmoidf_(float x) { return frcp(1.f + fexp2(-1.44269504089f * x)); }
DI float siluf_(float x) { return x * sigmoidf_(x); }
DI float gelu_tanh(float x) {
  float u = 0.7978845608028654f * (x + 0.044715f * x * x * x);
  float e = fexp2(2.885390081777927f * u);
  float th = 1.f - 2.f * frcp(1.f + e);
  return 0.5f * x * (1.f + th);
}
DI int get_tid(int wv) { int l; asm volatile("v_mbcnt_lo_u32_b32 %0, -1, 0\n\tv_mbcnt_hi_u32_b32 %0, -1, %0" : "=v"(l)); return wv * 64 + l; }
DI int get_bid() { int b = blockIdx.x; asm volatile("" : "+s"(b)); return b; }
DI int get_grid() { int g = gridDim.x; asm volatile("" : "+s"(g)); return g; }
DI int wave_of(int tid) { return __builtin_amdgcn_readfirstlane(tid >> 6); }
#define WVP const int WV,
DI float shflx(float v, int mask, int lane) { return __int_as_float(__builtin_amdgcn_ds_bpermute((lane ^ mask) << 2, __float_as_int(v))); }
DI int crow(int i, int h) { return (i & 3) + 8 * (i >> 2) + 4 * h; }
#define MFMA32(a, b, c) __builtin_amdgcn_mfma_f32_32x32x16_bf16((a), (b), (c), 0, 0, 0)
#define MFMA16(a, b, c) __builtin_amdgcn_mfma_f32_16x16x32_bf16((a), (b), (c), 0, 0, 0)
DI s16x4 tr_read(const char* p) { return __builtin_amdgcn_ds_read_tr16_b64_v4i16((LAS s16x4*)p); }
DI bf16x8 packP(const f32x16& x, int s) {
  unsigned a = pack2(x[8 * s], x[8 * s + 1]), b = pack2(x[8 * s + 2], x[8 * s + 3]);
  unsigned c = pack2(x[8 * s + 4], x[8 * s + 5]), d = pack2(x[8 * s + 6], x[8 * s + 7]);
  uint4 v = {a, b, c, d};
  return __builtin_bit_cast(bf16x8, v);
}

constexpr int BK = 64, HALF = 128, HT = HALF * BK;
DI int lds_byte(int r, int c) {
  int st = (r >> 4) * 2 + (c >> 5), rr = r & 15, cc = c & 31, ob = rr * 64 + cc * 2;
  return st * 1024 + (ob ^ (((ob >> 9) & 1) << 5));
}
DI void stage_rc(int b, int& R, int& C) {
  int st = b / 1024, sb = b % 1024, swz = sb ^ (((sb >> 9) & 1) << 5);
  R = (st >> 1) * 16 + swz / 64; C = (st & 1) * 32 + (swz % 64) / 2;
}

typedef f32x4 AccT[2][2][4][2];
DI void gemm_core(WVP char* smem, const u16* __restrict__ A, int lda, int ar0, int ar1,
                  const u16* __restrict__ B, int ldb, int bc0, int K, AccT& acc) {
  u16* shm = (u16*)smem;
#define SA(b, h) (shm + ((b) * 2 + (h)) * HT)
#define SB(b, h) (shm + (4 + (b) * 2 + (h)) * HT)
#define STAGE_A(P, br, kt) do { const char* _g = (const char*)(A + (long)(br) * lda + (long)(kt) * BK); \
    __builtin_amdgcn_global_load_lds((const unsigned*)(_g + (size_t)offA0), (unsigned*)((char*)(P) + sb0), 16, 0, 0); \
    __builtin_amdgcn_global_load_lds((const unsigned*)(_g + (size_t)lda * 128 + (size_t)offA0), (unsigned*)((char*)(P) + sb1), 16, 0, 0); } while (0)
#define STAGE_B(P, br, kt) do { const char* _g = (const char*)(B + (long)(br) * ldb + (long)(kt) * BK); \
    __builtin_amdgcn_global_load_lds((const unsigned*)(_g + (size_t)offB0), (unsigned*)((char*)(P) + sb0), 16, 0, 0); \
    __builtin_amdgcn_global_load_lds((const unsigned*)(_g + (size_t)ldb * 128 + (size_t)offB0), (unsigned*)((char*)(P) + sb1), 16, 0, 0); } while (0)
#define LDA(dst, b, h) for (int m = 0; m < 4; ++m) for (int k = 0; k < 2; ++k) \
    dst[m][k] = *reinterpret_cast<const bf16x8*>((char*)SA(b, h) + lds_byte(wr * 64 + m * 16 + fr, k * 32 + fq * 8))
#define LDB(dst, b, h) for (int n = 0; n < 2; ++n) for (int k = 0; k < 2; ++k) \
    dst[n][k] = *reinterpret_cast<const bf16x8*>((char*)SB(b, h) + lds_byte(wc * 32 + n * 16 + fr, k * 32 + fq * 8))
#define MMA(ai, bj, At_, Bt_) do { __builtin_amdgcn_s_setprio(1); \
    for (int m = 0; m < 4; ++m) for (int n = 0; n < 2; ++n) for (int k = 0; k < 2; ++k) \
      acc[ai][bj][m][n] = MFMA16(At_[m][k], Bt_[n][k], acc[ai][bj][m][n]); \
    __builtin_amdgcn_s_setprio(0); } while (0)
#define WAIT_V(n) asm volatile("s_waitcnt vmcnt(" #n ")" ::: "memory")
#define WAIT_L(n) asm volatile("s_waitcnt lgkmcnt(" #n ")" ::: "memory")
#define BAR __builtin_amdgcn_s_barrier()
#define SCHED __builtin_amdgcn_sched_barrier(0)

  const int tid = get_tid(WV);
  const int wid = wave_of(tid), lane = tid & 63, wr = wid >> 2, wc = wid & 3, fr = lane & 15, fq = lane >> 4;
  const int sb0 = tid * 16, sb1 = sb0 + 8192;
  int R0, C0; stage_rc(sb0, R0, C0);
  const unsigned offA0 = (unsigned)(R0 * lda + C0) * 2u, offB0 = (unsigned)(R0 * ldb + C0) * 2u;
  const int ac0 = ar0, ac1 = ar1, bb0 = bc0, bb1 = bc0 + HALF;
  bf16x8 At[4][2], B0[2][2], B1[2][2];
  const int nt = K / BK;
  __syncthreads();
  STAGE_B(SB(0, 0), bb0, 0); STAGE_A(SA(0, 0), ac0, 0);
  STAGE_B(SB(0, 1), bb1, 0); STAGE_A(SA(0, 1), ac1, 0);
  if (wr == 1) BAR;
  WAIT_V(4); BAR;
  STAGE_B(SB(1, 0), bb0, 1); STAGE_A(SA(1, 0), ac0, 1); STAGE_B(SB(1, 1), bb1, 1);
  WAIT_V(6); BAR;
  for (int t = 0; t < nt - 2; t += 2) {
    LDB(B0, 0, 0); SCHED; LDA(At, 0, 0); STAGE_A(SA(1, 1), ac1, t + 1);
    WAIT_L(8); BAR; WAIT_L(0); MMA(0, 0, At, B0); BAR; SCHED;
    LDB(B1, 0, 1); STAGE_B(SB(0, 0), bb0, t + 2);
    BAR; WAIT_L(0); MMA(0, 1, At, B1); BAR;
    LDA(At, 0, 1); STAGE_A(SA(0, 0), ac0, t + 2);
    BAR; WAIT_L(0); MMA(1, 0, At, B0); BAR; SCHED;
    STAGE_B(SB(0, 1), bb1, t + 2);
    WAIT_V(6); BAR; MMA(1, 1, At, B1); BAR;
    LDB(B0, 1, 0); SCHED; LDA(At, 1, 0); STAGE_A(SA(0, 1), ac1, t + 2);
    WAIT_L(8); BAR; WAIT_L(0); MMA(0, 0, At, B0); BAR; SCHED;
    LDB(B1, 1, 1); STAGE_B(SB(1, 0), bb0, t + 3);
    BAR; WAIT_L(0); MMA(0, 1, At, B1); BAR;
    LDA(At, 1, 1); STAGE_A(SA(1, 0), ac0, t + 3);
    BAR; WAIT_L(0); MMA(1, 0, At, B0); BAR; SCHED;
    STAGE_B(SB(1, 1), bb1, t + 3);
    WAIT_V(6); BAR; MMA(1, 1, At, B1); BAR;
  }
  { LDB(B0, 0, 0); LDA(At, 0, 0); STAGE_A(SA(1, 1), ac1, nt - 1);
    BAR; WAIT_L(0); MMA(0, 0, At, B0); BAR;
    LDB(B1, 0, 1); BAR; WAIT_L(0); MMA(0, 1, At, B1); BAR;
    LDA(At, 0, 1); WAIT_V(4); BAR; WAIT_L(0); MMA(1, 0, At, B0); MMA(1, 1, At, B1); BAR; }
  { LDB(B0, 1, 0); LDA(At, 1, 0); WAIT_V(2); BAR; WAIT_L(0); MMA(0, 0, At, B0); BAR;
    LDB(B1, 1, 1); WAIT_V(0); BAR; WAIT_L(0); MMA(0, 1, At, B1); BAR;
    LDA(At, 1, 1); BAR; WAIT_L(0); MMA(1, 0, At, B0); MMA(1, 1, At, B1); BAR; }
  if (wr == 0) BAR;
#undef SA
#undef SB
}
template <class Epi>
DI void apply_epi(WVP AccT& acc, int bc0, const Epi& epi) {
  const int t2 = get_tid(WV);
  const int wid2 = wave_of(t2), lane2 = t2 & 63, wr2 = wid2 >> 2, wc2 = wid2 & 3, fr2 = lane2 & 15, fq2 = lane2 >> 4;
  for (int bj = 0; bj < 2; ++bj) for (int m = 0; m < 4; ++m) {
    for (int n = 0; n < 2; ++n)
      epi(acc[0][bj][m][n], acc[1][bj][m][n], wr2 * 64 + m * 16 + fq2 * 4, bc0 + bj * HALF + wc2 * 32 + n * 16 + fr2, bj * 8 + m * 2 + n, t2);
    if (m & 1) __builtin_amdgcn_sched_barrier(0);
  }
}
template <class Epi>
DI void apply_epi_staged(WVP char* smem, AccT& acc, int bc0, const Epi& epi) {
  constexpr int NC = Epi::NC, PITCH = NC * 2 + 16;
  const int t2 = get_tid(WV);
  const int wid2 = wave_of(t2), lane2 = t2 & 63, wr2 = wid2 >> 2, wc2 = wid2 & 3, fr2 = lane2 & 15, fq2 = lane2 >> 4;
  for (int bj = 0; bj < 2; ++bj) for (int m = 0; m < 4; ++m) {
    for (int n = 0; n < 2; ++n) {
      const int rl = wr2 * 64 + m * 16 + fq2 * 4, tc = bj * HALF + wc2 * 32 + n * 16 + fr2;
      f32x4 r0, r1;
      epi.tr(acc[0][bj][m][n], acc[1][bj][m][n], rl, bc0 + tc, bj * 8 + m * 2 + n, t2, r0, r1);
      uint2 v0; v0.x = pack2(r0[0], r0[1]); v0.y = pack2(r0[2], r0[3]);
      *(uint2*)(smem + tc * PITCH + rl * 2) = v0;
      if (NC == 256) { uint2 v1; v1.x = pack2(r1[0], r1[1]); v1.y = pack2(r1[2], r1[3]); *(uint2*)(smem + tc * PITCH + (HALF + rl) * 2) = v1; }
    }
    if (m & 1) __builtin_amdgcn_sched_barrier(0);
  }
  __syncthreads();
  constexpr int CPR = NC / 8;
#pragma unroll
  for (int i = 0; i < 256 * CPR / NTHR; ++i) {
    const int L = i * NTHR + t2, row = L / CPR, ch = L % CPR;
    const u32x4 v = *(const u32x4*)(smem + row * PITCH + ch * 16);
    *(u32x4*)(epi.out(bc0 + row, ch)) = v;
  }
}
template <class Epi>
DI void gemm_tile(WVP char* smem, const u16* __restrict__ A, int lda, int ar0, int ar1,
                  const u16* __restrict__ B, int ldb, int bc0, int K, const Epi& epi) {
  AccT acc = {};
  gemm_core(WV, smem, A, lda, ar0, ar1, B, ldb, bc0, K, acc);
  apply_epi(WV, acc, bc0, epi);
}
template <class Epi>
DI void gemm_tile_staged(WVP char* smem, const u16* __restrict__ A, int lda, int ar0, int ar1,
                  const u16* __restrict__ B, int ldb, int bc0, int K, const Epi& epi) {
  AccT acc = {};
  gemm_core(WV, smem, A, lda, ar0, ar1, B, ldb, bc0, K, acc);
  apply_epi_staged(WV, smem, acc, bc0, epi);
}

DI void tile_map(int id, int nwg, int nR, int nC, int& pr, int& pc) {
  constexpr int NX = 8, WGM = 4;
  int q = nwg / NX, r = nwg % NX, xcd = id % NX, off = id / NX;
  id = (xcd < r ? xcd * (q + 1) : r * (q + 1) + (xcd - r) * q) + off;
  int nig = WGM * nC, gid = id / nig, fm = gid * WGM, gsz = min(nR - fm, WGM);
  pr = fm + ((id % nig) % gsz); pc = (id % nig) / gsz;
}

struct EpiStore2 { static constexpr int NC = 256; u16* dst; int ld; int n0, n1;
  DI void tr(const f32x4& a0, const f32x4& a1, int, int, int, int, f32x4& r0, f32x4& r1) const { r0 = a0; r1 = a1; }
  DI u16* out(int row, int ch) const { return dst + (long)row * ld + (ch < 16 ? n0 + ch * 8 : n1 + (ch - 16) * 8); } };
template <int ACT> struct EpiGated { static constexpr int NC = 128; u16* dst; int ld; int nb;
  DI void tr(const f32x4& a0, const f32x4& a1, int, int, int, int, f32x4& r0, f32x4& r1) const {
    for (int j = 0; j < 4; ++j) r0[j] = ACT == 0 ? siluf_(a0[j]) * a1[j] : a0[j] * sigmoidf_(a1[j]);
    r1 = r0; }
  DI u16* out(int row, int ch) const { return dst + (long)row * ld + nb + ch * 8; } };
struct EpiResid { const float* xin; float* xout; int n0, n1;
  DI void operator()(f32x4& a0, f32x4& a1, int rl, int col, int, int) const {
    f32x4 v0 = *(const f32x4*)(xin + (long)col * DM + n0 + rl), v1 = *(const f32x4*)(xin + (long)col * DM + n1 + rl);
    *(f32x4*)(xout + (long)col * DM + n0 + rl) = v0 + a0; *(f32x4*)(xout + (long)col * DM + n1 + rl) = v1 + a1; } };
DI u16* stash_ptr(u16* base, int ld, int bc0, int j, int tid) { const int L = j * NTHR + tid; return base + (long)(bc0 + (L >> 5)) * ld + (L & 31) * 8; }
DI void unpack8(const u32x4& v, f32x4& lo, f32x4& hi) { lo = f32x4{bflo(v[0]), bfhi(v[0]), bflo(v[1]), bfhi(v[1])}; hi = f32x4{bflo(v[2]), bfhi(v[2]), bflo(v[3]), bfhi(v[3])}; }
struct EpiSig { u16* dst; int ld; int bc0;
  DI void operator()(f32x4& a0, f32x4& a1, int, int, int j, int tid) const {
    f32x4 r0, r1;
    for (int q = 0; q < 4; ++q) { r0[q] = fmaxf(sigmoidf_(a0[q]), 1e-20f); r1[q] = fmaxf(sigmoidf_(a1[q]), 1e-20f); }
    u32x4 v = {pack2(r0[0], r0[1]), pack2(r0[2], r0[3]), pack2(r1[0], r1[1]), pack2(r1[2], r1[3])};
    *(u32x4*)stash_ptr(dst, ld, bc0, j, tid) = v; } };
struct EpiRescale { u16* sc; int ldc; u16* sn; int ldn; int bc0;
  DI void operator()(f32x4& a0, f32x4& a1, int, int, int j, int tid) const {
    const u32x4 vc = *(const u32x4*)stash_ptr(sc, ldc, bc0, j, tid), vn = *(const u32x4*)stash_ptr(sn, ldn, bc0, j, tid);
    f32x4 c0, c1, n0, n1; unpack8(vc, c0, c1); unpack8(vn, n0, n1);
    for (int q = 0; q < 4; ++q) { a0[q] *= c0[q] * frcp(n0[q]); a1[q] *= c1[q] * frcp(n1[q]); } } };
struct EpiFinalGate { static constexpr int NC = 256; u16* mg; int nbase; int bc0;
  DI void tr(const f32x4& a0, const f32x4& a1, int, int, int j, int tid, f32x4& r0, f32x4& r1) const {
    const u32x4 vc = *(const u32x4*)stash_ptr(mg + nbase, DM, bc0, j, tid);
    f32x4 c0, c1; unpack8(vc, c0, c1); r0 = a0 * c0; r1 = a1 * c1; }
  DI u16* out(int row, int ch) const { return mg + (long)row * DM + nbase + ch * 8; } };

typedef unsigned long long u64;
typedef __attribute__((address_space(1))) u64 gu64;
struct EpiNormOut { static constexpr int NC = 256; u16* xn; int n0; const float* g; const float* rsb; int bc0;
  DI void tr(const f32x4& a0, const f32x4& a1, int rl, int col, int, int, f32x4& r0, f32x4& r1) const {
    const float rs = rsb[col - bc0];
    const f32x4 g0 = *(const f32x4*)(g + n0 + rl), g1 = *(const f32x4*)(g + n0 + HALF + rl);
    r0 = a0 * g0 * rs; r1 = a1 * g1 * rs; }
  DI u16* out(int row, int ch) const { return xn + (long)row * DM + n0 + ch * 8; } };
DI void resid_norm_epi(WVP char* smem, AccT& acc, int bc0, const float* xin, float* xout, int n0, int pc, int pr, unsigned epoch,
                       u64* slab, const float* g, u16* xn, int mode) {
  const int t2 = get_tid(WV);
  const int wid2 = wave_of(t2), lane2 = t2 & 63, wr2 = wid2 >> 2, wc2 = wid2 & 3, fr2 = lane2 & 15, fq2 = lane2 >> 4;
  float* part = (float*)(smem + 139264);
  float* rsb = part + 512;
  float sq[2][2] = {{0.f, 0.f}, {0.f, 0.f}};
  for (int bj = 0; bj < 2; ++bj) for (int m = 0; m < 4; ++m) {
    for (int n = 0; n < 2; ++n) {
      const int rl = wr2 * 64 + m * 16 + fq2 * 4, col = bc0 + bj * HALF + wc2 * 32 + n * 16 + fr2;
      const f32x4 v0 = *(const f32x4*)(xin + (long)col * DM + n0 + rl) + acc[0][bj][m][n], v1 = *(const f32x4*)(xin + (long)col * DM + n0 + HALF + rl) + acc[1][bj][m][n];
      if (mode != 2) { *(f32x4*)(xout + (long)col * DM + n0 + rl) = v0; *(f32x4*)(xout + (long)col * DM + n0 + HALF + rl) = v1; }
      acc[0][bj][m][n] = v0; acc[1][bj][m][n] = v1;
      sq[bj][n] += v0[0] * v0[0] + v0[1] * v0[1] + v0[2] * v0[2] + v0[3] * v0[3] + v1[0] * v1[0] + v1[1] * v1[1] + v1[2] * v1[2] + v1[3] * v1[3];
    }
    if (m & 1) __builtin_amdgcn_sched_barrier(0);
  }
  for (int bj = 0; bj < 2; ++bj) for (int n = 0; n < 2; ++n) {
    float sv = sq[bj][n]; sv += shflx(sv, 16, lane2); sv += shflx(sv, 32, lane2);
    if (fq2 == 0) part[wr2 * 256 + bj * HALF + wc2 * 32 + n * 16 + fr2] = sv;
  }
  __syncthreads();
  if (t2 < 256) {
    const float tot = part[t2] + part[256 + t2];
    __hip_atomic_store((gu64*)(slab + ((size_t)(pc * 4 + pr) * 256 + t2)), ((u64)epoch << 32) | (u64)__float_as_uint(tot), __ATOMIC_RELAXED, __HIP_MEMORY_SCOPE_AGENT);
    gu64* gb = (gu64*)(slab + ((size_t)(pc * 4) * 256 + t2));
    float sum = 0.f;
    for (unsigned spins = 0;; ++spins) {
      bool ok = true; sum = 0.f;
#pragma unroll
      for (int q = 0; q < 4; ++q) { const u64 x = __hip_atomic_load(gb + q * 256, __ATOMIC_RELAXED, __HIP_MEMORY_SCOPE_AGENT); ok &= (unsigned)(x >> 32) == epoch; sum += __uint_as_float((unsigned)x); }
      if (__all(ok) || spins > (1u << 22)) break;
      __builtin_amdgcn_s_sleep(1);
    }
    rsb[t2] = rsqrtf(sum * (1.f / DM) + 1e-6f);
  }
  __syncthreads();
  if (mode == 1) { EpiNormOut E{xn, n0, g, rsb, bc0}; apply_epi_staged(WV, smem, acc, bc0, E); }
  if (mode == 2) {
    for (int bj = 0; bj < 2; ++bj) for (int m = 0; m < 4; ++m) {
      for (int n = 0; n < 2; ++n) {
        const int rl = wr2 * 64 + m * 16 + fq2 * 4, tc = bj * HALF + wc2 * 32 + n * 16 + fr2;
        const float rs = rsb[tc];
        const f32x4 g0 = *(const f32x4*)(g + n0 + rl), g1 = *(const f32x4*)(g + n0 + HALF + rl);
        *(f32x4*)(xout + (long)(bc0 + tc) * DM + n0 + rl) = acc[0][bj][m][n] * g0 * rs;
        *(f32x4*)(xout + (long)(bc0 + tc) * DM + n0 + HALF + rl) = acc[1][bj][m][n] * g1 * rs;
      }
      if (m & 1) __builtin_amdgcn_sched_barrier(0);
    }
  }
}

DI void phase_rmsnorm(WVP const float* __restrict__ x, const float* __restrict__ g, u16* __restrict__ o) {
  const int BID = get_bid(), GRD = get_grid();
  const int tid = get_tid(WV), wave = wave_of(tid), lane = tid & 63;
  f32x4 gv[4];
  for (int i = 0; i < 4; ++i) gv[i] = *(const f32x4*)(g + i * 256 + lane * 4);
  for (int row = BID * 8 + wave; row < TOK; row += GRD * 8) {
    f32x4 v[4]; float ss = 0.f;
    for (int i = 0; i < 4; ++i) { v[i] = *(const f32x4*)(x + (long)row * DM + i * 256 + lane * 4); ss += v[i][0] * v[i][0] + v[i][1] * v[i][1] + v[i][2] * v[i][2] + v[i][3] * v[i][3]; }
    for (int d = 32; d >= 1; d >>= 1) ss += shflx(ss, d, lane);
    float rs = rsqrtf(ss * (1.f / DM) + 1e-6f);
    for (int i = 0; i < 4; ++i) store4bf(o + (long)row * DM + i * 256 + lane * 4, v[i] * rs * gv[i]);
  }
}
DI void phase_final_norm(WVP float* __restrict__ x, const float* __restrict__ g) {
  const int BID = get_bid(), GRD = get_grid();
  const int tid = get_tid(WV), wave = wave_of(tid), lane = tid & 63;
  f32x4 gv[4];
  for (int i = 0; i < 4; ++i) gv[i] = *(const f32x4*)(g + i * 256 + lane * 4);
  for (int row = BID * 8 + wave; row < TOK; row += GRD * 8) {
    f32x4 v[4]; float ss = 0.f;
    for (int i = 0; i < 4; ++i) { v[i] = *(const f32x4*)(x + (long)row * DM + i * 256 + lane * 4); ss += v[i][0] * v[i][0] + v[i][1] * v[i][1] + v[i][2] * v[i][2] + v[i][3] * v[i][3]; }
    for (int d = 32; d >= 1; d >>= 1) ss += shflx(ss, d, lane);
    float rs = rsqrtf(ss * (1.f / DM) + 1e-6f);
    for (int i = 0; i < 4; ++i) *(f32x4*)(x + (long)row * DM + i * 256 + lane * 4) = v[i] * rs * gv[i];
  }
}

DI void transpose_tile(WVP float* sm, const float* __restrict__ src, int lds_, u16* __restrict__ dst, int ldd, int k0, int n0) {
  const int tid = get_tid(WV);
  constexpr int P = 257;
  f32x4 v[8];
  const int rb = tid >> 6, c4 = (tid & 63) * 4;
#pragma unroll
  for (int i = 0; i < 8; ++i) v[i] = *(const f32x4*)(src + (long)(k0 + rb + 8 * i) * lds_ + n0 + c4);
  __syncthreads();
#pragma unroll
  for (int i = 0; i < 8; ++i) for (int j = 0; j < 4; ++j) sm[(rb + 8 * i) * P + c4 + j] = v[i][j];
  __syncthreads();
#pragma unroll
  for (int i = 0; i < 4; ++i) {
    const int c = tid + NTHR * i, n = c >> 3, k8 = (c & 7) * 8;
    u32x4 o;
    o[0] = pack2(sm[(k8 + 0) * P + n], sm[(k8 + 1) * P + n]); o[1] = pack2(sm[(k8 + 2) * P + n], sm[(k8 + 3) * P + n]);
    o[2] = pack2(sm[(k8 + 4) * P + n], sm[(k8 + 5) * P + n]); o[3] = pack2(sm[(k8 + 6) * P + n], sm[(k8 + 7) * P + n]);
    *(u32x4*)(dst + (long)(n0 + n) * ldd + k0 + k8) = o;
  }
}
DI void phase_wprep(WVP CP pp, int l, char* smem, int mask) {
  const int BID = get_bid(), GRD = get_grid();
  char* ws = pp->ws;
  float* sm = (float*)smem;
  const float* w_in = pp->in[2] + (size_t)l * DM * INW;
  const float* w_gate = pp->in[16] + (size_t)l * 4 * DM * DM;
  const float* w_branch = pp->in[15] + (size_t)l * 1792 * DM;
  const float* w_out = pp->in[17] + (size_t)l * DM * DM;
  const float* w_up = pp->in[19] + (size_t)l * DM * 2 * FFN;
  const float* w_down = pp->in[20] + (size_t)l * FFN * DM;
  const float* w_glu = pp->in[14] + (size_t)l * 512 * 1024;
  u16* WB = (u16*)(ws + WS_WB);
  constexpr int NJ = 12;
  const float* src[NJ] = {w_in, w_gate, w_gate + DM * DM, w_gate + 2 * DM * DM, w_gate + 3 * DM * DM,
                          w_branch + 512 * DM, w_branch + 768 * DM, w_branch + 1280 * DM, w_out, w_up, w_down, w_glu};
  const int lds_[NJ] = {INW, DM, DM, DM, DM, DM, DM, DM, DM, 2 * FFN, DM, 1024};
  const int Kd[NJ] = {DM, DM, DM, DM, DM, 256, 512, 512, DM, DM, FFN, 512};
  const int Nd[NJ] = {INW, DM, DM, DM, DM, DM, DM, DM, DM, 2 * FFN, DM, 1024};
  u16* dst[NJ] = {(u16*)(ws + WS_WIN), (u16*)(ws + WS_WG), (u16*)(ws + WS_WG) + DM * DM, (u16*)(ws + WS_WG) + 2 * DM * DM, (u16*)(ws + WS_WG) + 3 * DM * DM,
                  WB + DM * 512, WB + DM * 768, WB + DM * 1280, (u16*)(ws + WS_WO), (u16*)(ws + WS_WUP), (u16*)(ws + WS_WDN), (u16*)(ws + WS_WGLU)};
  int base = 0;
#pragma unroll
  for (int j = 0; j < NJ; ++j) {
    if (!((mask >> j) & 1)) continue;
    int nk = Kd[j] / 64, nn = Nd[j] / 256, cnt = nk * nn;
    int first = (BID - base % GRD + GRD) % GRD;
    for (int i = first; i < cnt; i += GRD) transpose_tile(WV, sm, src[j], lds_[j], dst[j], Kd[j], (i / nn) * 64, (i % nn) * 256);
    base += cnt;
  }
  const float* pool_w = pp->in[3] + (size_t)l * 4 * 128 * 128;
  const float* pool_s = pp->in[4] + (size_t)l * 512;
  for (int it = GRD - 1 - BID; it < (((mask >> 12) & 1) ? 16 * 16 : 0); it += GRD) {
    const int k0 = (it >> 4) * 32, n0 = (it & 15) * 64;
    const int tid = get_tid(WV);
    const int n = n0 + (tid & 63), kb = k0 + (tid >> 6) * 4, g = kb >> 7;
    float accv[4] = {0, 0, 0, 0};
    const float* pw = pool_w + (size_t)(g * 128 + (kb & 127)) * 128;
#pragma unroll 2
    for (int d = 0; d < 128; d += 4) {
      const f32x4 ps = *(const f32x4*)(pool_s + g * 128 + d);
      float wv[4];
      for (int q = 0; q < 4; ++q) wv[q] = ps[q] * w_branch[(long)(g * 128 + d + q) * DM + n];
      for (int jj = 0; jj < 4; ++jj) {
        const f32x4 p4 = *(const f32x4*)(pw + jj * 128 + d);
        accv[jj] += p4[0] * wv[0] + p4[1] * wv[1] + p4[2] * wv[2] + p4[3] * wv[3];
      }
    }
    uint2 o; o.x = pack2(accv[0], accv[1]); o.y = pack2(accv[2], accv[3]);
    *(uint2*)(WB + (long)n * 512 + kb) = o;
  }
}

DI void mix_pool(WVP const u16* __restrict__ proj, u16* __restrict__ pb) {
  const int BID = get_bid(), GRD = get_grid();
  const int tid = get_tid(WV);
  for (int idx = BID * NTHR + tid; idx < (TOK / 16) * 64; idx += GRD * NTHR) {
    const int cc = idx & 63, t0 = (idx >> 6) * 16, gi = cc >> 4, w = 2 << gi, s0 = t0 & (SEQ - 1);
    const u16* base = proj + (long)t0 * INW + cc * 8;
    float a[8] = {0, 0, 0, 0, 0, 0, 0, 0};
    for (int i = 1; i < w; ++i) {
      if (s0 - i >= 0) {
        const u32x4 v = *(const u32x4*)(base - (long)i * INW);
        a[0] += bflo(v[0]); a[1] += bfhi(v[0]); a[2] += bflo(v[1]); a[3] += bfhi(v[1]); a[4] += bflo(v[2]); a[5] += bfhi(v[2]); a[6] += bflo(v[3]); a[7] += bfhi(v[3]);
      }
    }
#pragma unroll 4
    for (int k = 0; k < 16; ++k) {
      const int s = s0 + k;
      const u32x4 v = *(const u32x4*)(base + (long)k * INW);
      float u[8] = {bflo(v[0]), bfhi(v[0]), bflo(v[1]), bfhi(v[1]), bflo(v[2]), bfhi(v[2]), bflo(v[3]), bfhi(v[3])};
      for (int q = 0; q < 8; ++q) a[q] += u[q];
      const float ic = 1.f / (float)min(w, s + 1);
      u32x4 o;
      o[0] = pack2(a[0] * ic - u[0], a[1] * ic - u[1]); o[1] = pack2(a[2] * ic - u[2], a[3] * ic - u[3]);
      o[2] = pack2(a[4] * ic - u[4], a[5] * ic - u[5]); o[3] = pack2(a[6] * ic - u[6], a[7] * ic - u[7]);
      *(u32x4*)(pb + (long)(t0 + k) * 512 + cc * 8) = o;
      if (s - w + 1 >= 0) {
        const u32x4 x = *(const u32x4*)(base + (long)(k - w + 1) * INW);
        a[0] -= bflo(x[0]); a[1] -= bfhi(x[0]); a[2] -= bflo(x[1]); a[3] -= bfhi(x[1]); a[4] -= bflo(x[2]); a[5] -= bfhi(x[2]); a[6] -= bflo(x[3]); a[7] -= bfhi(x[3]);
      }
    }
  }
}

DI int t5_bucket(int dist) {
  if (dist < 16) return dist;
  const int thr[15] = {22, 30, 40, 54, 73, 99, 134, 182, 246, 332, 450, 609, 825, 1117, 1513};
  int b = 16;
#pragma unroll
  for (int k = 0; k < 15; ++k) b += (dist >= thr[k]) ? 1 : 0;
  return b;
}
DI void mix_dil(WVP u16* __restrict__ proj, float* __restrict__ lse, const float* __restrict__ rel_bias, char* smem) {
  const int BID = get_bid(), GRD = get_grid();
  const int tid = get_tid(WV), wave = wave_of(tid), lane = tid & 63, h = lane >> 5, l31 = lane & 31;
  float* btab = (float*)smem;
  char* vbuf = smem + 12 * 132 * 4 + wave * 4608;
  __syncthreads();
  for (int i = tid; i < 12 * 129; i += NTHR) {
    int H = i / 129, ds = i % 129, g = H >> 2; int dil = g == 0 ? 1 : (g == 1 ? 4 : 16);
    btab[H * 132 + ds] = rel_bias[t5_bucket(ds * dil) * 12 + H] * 1.44269504089f;
  }
  __syncthreads();
  const float sc = 1.44269504089f * 0.125f;
  const int i16 = lane & 15, tq = i16 >> 2, tp = i16 & 3, blk = (lane >> 4) & 1;
#define DIL_DECODE(u_, tb_, q0_, H_, dil_, j0_) \
    const int v_ = (u_) & 127, hh_ = ((u_) >> 7) & 3, g_ = ((u_) >> 9) % 3, b_ = (u_) / (512 * 3); \
    const int dsh_ = g_ * 2; dil_ = 1 << dsh_; const int nq_ = (SEQ >> dsh_) >> 5; \
    const int r_ = v_ / nq_; q0_ = (v_ % nq_) * 32; H_ = g_ * 4 + hh_; tb_ = (long)b_ * SEQ + r_; j0_ = q0_ >= 128 ? 0 : (128 - q0_) >> 5;
  bf16x8 bq_n[4], ak_n[4]; u32x4 vv_n[4];
  const int u_first = BID * 8 + wave, u_step = GRD * 8, u_end = BATCH * 3 * 4 * 128;
  if (u_first < u_end) {
    long tb; int q0, H, dil, j0; DIL_DECODE(u_first, tb, q0, H, dil, j0)
    const u16* qp = proj + (tb + (long)(q0 + l31) * dil) * INW + O1 + H * 64;
    for (int s = 0; s < 4; ++s) bq_n[s] = *(const bf16x8*)(qp + 16 * s + 8 * h);
    const u16* kp = proj + (tb + (long)(q0 - 128 + 32 * j0 + l31) * dil) * INW + O1 + 768 + H * 64;
    for (int s = 0; s < 4; ++s) ak_n[s] = *(const bf16x8*)(kp + 16 * s + 8 * h);
    for (int c = 0; c < 4; ++c) vv_n[c] = *(const u32x4*)(kp + 768 + h * 32 + c * 8);
  }
#pragma nounroll
  for (int u = u_first; u < u_end; u += u_step) {
    long tbase; int q0, H, dil, j0; DIL_DECODE(u, tbase, q0, H, dil, j0)
    u16* qp = proj + (tbase + (long)(q0 + l31) * dil) * INW + O1 + H * 64;
    bf16x8 bq[4];
    for (int s = 0; s < 4; ++s) bq[s] = bq_n[s];
    f32x16 O[2]; for (int e = 0; e < 2; ++e) for (int i = 0; i < 16; ++i) O[e][i] = 0.f;
    float mrun = -1e30f, lsum = 0.f;
    const float* bt = btab + H * 132;
    const u16* kbase_ = proj + tbase * INW + O1 + 768 + H * 64;
    f32x16 sacc; for (int i = 0; i < 16; ++i) sacc[i] = 0.f;
    for (int s = 0; s < 4; ++s) sacc = MFMA32(ak_n[s], bq[s], sacc);
    u32x4 vv[4];
    for (int c = 0; c < 4; ++c) vv[c] = vv_n[c];
    if (j0 + 1 < 5) {
      const u16* kp = kbase_ + (long)(q0 - 128 + 32 * (j0 + 1) + l31) * dil * INW;
      for (int s = 0; s < 4; ++s) ak_n[s] = *(const bf16x8*)(kp + 16 * s + 8 * h);
      for (int c = 0; c < 4; ++c) vv_n[c] = *(const u32x4*)(kp + 768 + h * 32 + c * 8);
    }
#pragma nounroll
    for (int j = j0; j < 5; ++j) {
      const int kb = q0 - 128 + 32 * j;
      for (int c = 0; c < 4; ++c) *(u32x4*)(vbuf + l31 * 144 + h * 64 + c * 16) = vv[c];
      f32x16 snx; for (int i = 0; i < 16; ++i) snx[i] = 0.f;
      if (j + 1 < 5) {
        for (int s = 0; s < 4; ++s) snx = MFMA32(ak_n[s], bq[s], snx);
        for (int c = 0; c < 4; ++c) vv[c] = vv_n[c];
        if (j + 2 < 5) {
          const u16* kp = kbase_ + (long)(kb + 64 + l31) * dil * INW;
          for (int s = 0; s < 4; ++s) ak_n[s] = *(const bf16x8*)(kp + 16 * s + 8 * h);
          for (int c = 0; c < 4; ++c) vv_n[c] = *(const u32x4*)(kp + 768 + h * 32 + c * 8);
        }
      }
      if (j == 4 && u + u_step < u_end) {
        long tb2; int q02, H2, dil2, j02; DIL_DECODE(u + u_step, tb2, q02, H2, dil2, j02)
        const u16* qp2 = proj + (tb2 + (long)(q02 + l31) * dil2) * INW + O1 + H2 * 64;
        for (int s = 0; s < 4; ++s) bq_n[s] = *(const bf16x8*)(qp2 + 16 * s + 8 * h);
        const u16* kp = proj + (tb2 + (long)(q02 - 128 + 32 * j02 + l31) * dil2) * INW + O1 + 768 + H2 * 64;
        for (int s = 0; s < 4; ++s) ak_n[s] = *(const bf16x8*)(kp + 16 * s + 8 * h);
        for (int c = 0; c < 4; ++c) vv_n[c] = *(const u32x4*)(kp + 768 + h * 32 + c * 8);
      }
      float mx = -1e30f;
      for (int i = 0; i < 16; ++i) {
        int dist = (q0 + l31) - (kb + crow(i, h));
        bool ok = (dist >= 0) && (dist <= 128);
        int di = min(max(dist, 0), 128);
        float s2 = sacc[i] * sc + bt[di];
        s2 = ok ? s2 : -1e30f;
        sacc[i] = s2; mx = fmaxf(mx, s2);
      }
      mx = fmaxf(mx, shflx(mx, 32, lane));
      float mnew = fmaxf(mrun, mx);
      float alpha = fexp2(mrun - mnew);
      float ps = 0.f;
      for (int i = 0; i < 16; ++i) { float pv = sacc[i] > -1e29f ? fexp2(sacc[i] - mnew) : 0.f; sacc[i] = pv; ps += pv; }
      lsum = lsum * alpha + ps; mrun = mnew;
      for (int e = 0; e < 2; ++e) for (int i = 0; i < 16; ++i) O[e][i] *= alpha;
      __builtin_amdgcn_wave_barrier();
      for (int s = 0; s < 2; ++s) {
        bf16x8 pf = packP(sacc, s);
        for (int e = 0; e < 2; ++e) {
          s16x4 lo = tr_read(vbuf + (16 * s + 4 * h + tq) * 144 + e * 64 + 32 * blk + 8 * tp);
          s16x4 hi = tr_read(vbuf + (16 * s + 8 + 4 * h + tq) * 144 + e * 64 + 32 * blk + 8 * tp);
          bf16x8 av = __builtin_shufflevector(lo, hi, 0, 1, 2, 3, 4, 5, 6, 7);
          O[e] = MFMA32(av, pf, O[e]);
        }
      }
      __builtin_amdgcn_wave_barrier();
      sacc = snx;
    }
    float ltot = lsum + shflx(lsum, 32, lane);
    float inv = 1.f / ltot;
    for (int e = 0; e < 2; ++e) for (int gq = 0; gq < 4; ++gq) {
      f32x4 o4 = {O[e][4 * gq] * inv, O[e][4 * gq + 1] * inv, O[e][4 * gq + 2] * inv, O[e][4 * gq + 3] * inv};
      store4bf(qp + 32 * e + 8 * gq + 4 * h, o4);
    }
    if (h == 0) lse[(tbase + (long)(q0 + l31) * dil) * 12 + H] = (mrun + flog2(ltot)) * 0.6931471805599453f;
  }
}

DI void mix_dil_merge(WVP u16* __restrict__ proj, const float* __restrict__ lse) {
  const int BID = get_bid(), GRD = get_grid();
  const int tid = get_tid(WV);
  for (long idx = (long)BID * NTHR + tid; idx < (long)TOK * 32; idx += (long)GRD * NTHR) {
    int c8 = (int)(idx & 7), j = (int)(idx >> 3) & 3; long tok = idx >> 5;
    float l0 = lse[tok * 12 + j], l1 = lse[tok * 12 + 4 + j], l2 = lse[tok * 12 + 8 + j];
    float m = fmaxf(l0, fmaxf(l1, l2));
    float e0 = __expf(l0 - m), e1 = __expf(l1 - m), e2 = __expf(l2 - m), inv = 1.f / (e0 + e1 + e2);
    e0 *= inv; e1 *= inv; e2 *= inv;
    u16* base = proj + tok * INW + O1 + j * 64 + c8 * 8;
    uint4 a = *(const uint4*)base, b = *(const uint4*)(base + 256), c = *(const uint4*)(base + 512), o;
    o.x = pack2(e0 * bflo(a.x) + e1 * bflo(b.x) + e2 * bflo(c.x), e0 * bfhi(a.x) + e1 * bfhi(b.x) + e2 * bfhi(c.x));
    o.y = pack2(e0 * bflo(a.y) + e1 * bflo(b.y) + e2 * bflo(c.y), e0 * bfhi(a.y) + e1 * bfhi(b.y) + e2 * bfhi(c.y));
    o.z = pack2(e0 * bflo(a.z) + e1 * bflo(b.z) + e2 * bflo(c.z), e0 * bfhi(a.z) + e1 * bfhi(b.z) + e2 * bfhi(c.z));
    o.w = pack2(e0 * bflo(a.w) + e1 * bflo(b.w) + e2 * bflo(c.w), e0 * bfhi(a.w) + e1 * bfhi(b.w) + e2 * bfhi(c.w));
    *(uint4*)base = o;
  }
}

DI void mix_sb(WVP u16* __restrict__ proj, char* smem) {
  const int BID = get_bid(), GRD = get_grid();
  const int tid = get_tid(WV), wave = wave_of(tid), lane = tid & 63, h = lane >> 5, l31 = lane & 31;
  constexpr int RS = 272, TB = 32 * RS;
  char* kbuf = smem; char* vbuf = smem + 2 * TB; int* flags = (int*)(smem + 4 * TB);
  const int i16 = lane & 15, tq = i16 >> 2, tp = i16 & 3, blk = (lane >> 4) & 1;
  const float sc = 1.44269504089f * 0.08838834764831845f;
  const float RTH = -60.f;
  const int lrow = tid >> 4, lch = tid & 15;
  for (int it = BID; it < BATCH * 4 * 16; it += GRD) {
    int qb = 15 - (it & 15), hh = (it >> 4) & 3, b = it >> 6;
    int Q0 = qb * 256;
    u16* base = proj + (long)b * SEQ * INW + O2 + hh * 128;
    u16* qp = base + (long)(Q0 + 32 * wave + l31) * INW;
    bf16x8 bq[8];
    for (int s = 0; s < 8; ++s) bq[s] = *(const bf16x8*)(qp + 16 * s + 8 * h);
    f32x16 O[4]; for (int e = 0; e < 4; ++e) for (int i = 0; i < 16; ++i) O[e][i] = 0.f;
    float R = 0.f;
    const int kt_hi = Q0 / 32 + 7, kt_diag = Q0 / 32 + wave;
    __syncthreads();
    if (tid < 16) flags[tid] = 0;
    {
      const u16* kp = base + 512 + (long)(kt_hi * 32 + lrow) * INW + lch * 8;
      uint4 kv = *(const uint4*)kp, vv = *(const uint4*)(kp + 512);
      *(uint4*)(kbuf + lrow * RS + lch * 16) = kv; *(uint4*)(vbuf + lrow * RS + lch * 16) = vv;
    }
    __syncthreads();
    int cur = 0, iter = 0;
    for (int kt = kt_hi; kt >= 0; --kt, ++iter) {
      uint4 kv, vv;
      const bool more = kt > 0;
      if (more) { const u16* kp = base + 512 + (long)((kt - 1) * 32 + lrow) * INW + lch * 8; kv = *(const uint4*)kp; vv = *(const uint4*)(kp + 512); }
      bool wdone = false;
      if (kt <= kt_diag) {
        const char* kb_ = kbuf + cur * TB; const char* vb_ = vbuf + cur * TB;
        f32x16 sacc; for (int i = 0; i < 16; ++i) sacc[i] = 0.f;
        for (int s = 0; s < 8; ++s) { bf16x8 ak = *(const bf16x8*)(kb_ + l31 * RS + 32 * s + 16 * h); sacc = MFMA32(ak, bq[s], sacc); }
        const bool diag = (kt == kt_diag);
        float ls[16];
        for (int i = 0; i < 16; ++i) {
          float z2 = sacc[i] * sc;
          float sp = fmaxf(z2, 0.f) + flog2(1.f + fexp2(-fabsf(z2)));
          bool ok = !diag || (crow(i, h) < l31);
          ls[i] = ok ? -sp : 0.f;
          sacc[i] = ok ? z2 : -1e30f;
        }
        float G[4], Gp[4], tot[4];
        for (int g = 0; g < 4; ++g) G[g] = (ls[4 * g] + ls[4 * g + 1]) + (ls[4 * g + 2] + ls[4 * g + 3]);
        for (int g = 0; g < 4; ++g) { Gp[g] = shflx(G[g], 32, lane); tot[g] = G[g] + Gp[g]; }
        float after = 0.f;
        for (int g = 3; g >= 0; --g) {
          float tail = R + after + (h == 0 ? Gp[g] : 0.f);
          float c3 = tail + ls[4 * g + 3], c2 = c3 + ls[4 * g + 2], c1 = c2 + ls[4 * g + 1], c0 = c1 + ls[4 * g];
          sacc[4 * g + 3] = fexp2(sacc[4 * g + 3] + c3); sacc[4 * g + 2] = fexp2(sacc[4 * g + 2] + c2);
          sacc[4 * g + 1] = fexp2(sacc[4 * g + 1] + c1); sacc[4 * g] = fexp2(sacc[4 * g] + c0);
          after += tot[g];
        }
        R += after;
        for (int s = 0; s < 2; ++s) {
          bf16x8 pf = packP(sacc, s);
          for (int e = 0; e < 4; ++e) {
            s16x4 lo = tr_read(vb_ + (16 * s + 4 * h + tq) * RS + e * 64 + 32 * blk + 8 * tp);
            s16x4 hi = tr_read(vb_ + (16 * s + 8 + 4 * h + tq) * RS + e * 64 + 32 * blk + 8 * tp);
            bf16x8 av = __builtin_shufflevector(lo, hi, 0, 1, 2, 3, 4, 5, 6, 7);
            O[e] = MFMA32(av, pf, O[e]);
          }
        }
        wdone = __all(R < RTH);
      }
      if (lane == 0) flags[(iter & 1) * 8 + wave] = wdone ? 1 : 0;
      if (more) { *(uint4*)(kbuf + (cur ^ 1) * TB + lrow * RS + lch * 16) = kv; *(uint4*)(vbuf + (cur ^ 1) * TB + lrow * RS + lch * 16) = vv; }
      __syncthreads();
      cur ^= 1;
      int nd = 0;
      for (int w2 = 0; w2 < 8; ++w2) nd += flags[(iter & 1) * 8 + w2];
      if (nd == 8) break;
    }
    for (int e = 0; e < 4; ++e) for (int gq = 0; gq < 4; ++gq) {
      f32x4 o4 = {O[e][4 * gq], O[e][4 * gq + 1], O[e][4 * gq + 2], O[e][4 * gq + 3]};
      store4bf(qp + 32 * e + 8 * gq + 4 * h, o4);
    }
  }
}

DI void mix_s5(WVP CP pp, int l, u16* __restrict__ proj, char* smem) {
  const int BID = get_bid(), GRD = get_grid();
  const int tid = get_tid(WV), wave = wave_of(tid), lane = tid & 63, h = lane >> 5, l31 = lane & 31;
  constexpr int RSF = 132;
  float* buf = (float*)smem + wave * 32 * RSF;
  float* hend = (float*)(smem + 8 * 32 * RSF * 4);
  for (int it = BID; it < BATCH * 32; it += GRD) {
    const int g = it & 31, b = it >> 5;
    const float* a_re = pp->in[6] + ((size_t)l * 32 + g) * 64;
    const float* a_im = pp->in[7] + ((size_t)l * 32 + g) * 64;
    const float dt = __expf(pp->in[8][l * 32 + g]);
    const float* b_re = pp->in[9] + ((size_t)l * 32 + g) * 64 * 16;
    const float* b_im = pp->in[10] + ((size_t)l * 32 + g) * 64 * 16;
    const float* c_re = pp->in[11] + ((size_t)l * 32 + g) * 16 * 64;
    const float* c_im = pp->in[12] + ((size_t)l * 32 + g) * 16 * 64;
    const float* dsk = pp->in[13] + (size_t)l * 512 + g * 16;
    float lr, li;
    { float ar = a_re[lane], ai = a_im[lane]; float mg = expf(ar * dt); float sn, cs; sincosf(ai * dt, &sn, &cs); lr = mg * cs; li = mg * sn; }
    bf16x8 bfrag[4];
    float lam_r[2], lam_i[2];
    for (int half = 0; half < 2; ++half) {
      int ps = 32 * half + l31;
      float ar = a_re[ps], ai = a_im[ps]; float mg = expf(ar * dt); float sn, cs; sincosf(ai * dt, &sn, &cs);
      lam_r[half] = mg * cs; lam_i[half] = mg * sn;
      float xr = mg * cs - 1.f, xi = mg * sn, den = 1.f / (ar * ar + ai * ai);
      float cr = (xr * ar + xi * ai) * den, ci = (xi * ar - xr * ai) * den;
      float vr[8], vi[8];
      for (int j = 0; j < 8; ++j) { float br = b_re[ps * 16 + 8 * h + j], bi = b_im[ps * 16 + 8 * h + j]; vr[j] = cr * br - ci * bi; vi[j] = cr * bi + ci * br; }
      uint4 a = {pack2(vr[0], vr[1]), pack2(vr[2], vr[3]), pack2(vr[4], vr[5]), pack2(vr[6], vr[7])};
      uint4 c = {pack2(vi[0], vi[1]), pack2(vi[2], vi[3]), pack2(vi[4], vi[5]), pack2(vi[6], vi[7])};
      bfrag[half] = __builtin_bit_cast(bf16x8, a); bfrag[2 + half] = __builtin_bit_cast(bf16x8, c);
    }
    bf16x8 cfrag[4];
    { int c = lane & 15, kq = lane >> 4;
      for (int s = 0; s < 4; ++s) {
        float v[8];
        for (int j = 0; j < 8; ++j) { int k = 32 * s + 8 * kq + j; v[j] = k < 64 ? c_re[c * 64 + k] : -c_im[c * 64 + k - 64]; }
        uint4 a = {pack2(v[0], v[1]), pack2(v[2], v[3]), pack2(v[4], v[5]), pack2(v[6], v[7])};
        cfrag[s] = __builtin_bit_cast(bf16x8, a);
      } }
    const float dskip = dsk[lane & 15];
    u16* ub = proj + ((long)b * SEQ + wave * 512) * INW + O3 + g * 16;
    float hr = 0.f, hi = 0.f;
    __syncthreads();
    if (wave < 7) {
      float Hr[2] = {0.f, 0.f}, Hi[2] = {0.f, 0.f};
      float wre[2][16], wim[2][16], l32r[2], l32i[2];
      for (int half = 0; half < 2; ++half) {
        const float ar = lam_r[half], ai = lam_i[half];
        const float l2r = ar * ar - ai * ai, l2i = 2.f * ar * ai;
        const float l4r = l2r * l2r - l2i * l2i, l4i = 2.f * l2r * l2i;
        const float l5r = l4r * ar - l4i * ai, l5i = l4r * ai + l4i * ar;
        const float l8r = l4r * l4r - l4i * l4i, l8i = 2.f * l4r * l4i;
        const float l16r = l8r * l8r - l8i * l8i, l16i = 2.f * l8r * l8i;
        l32r[half] = l16r * l16r - l16i * l16i; l32i[half] = 2.f * l16r * l16i;
        float cr = h ? 1.f : l4r, ci = h ? 0.f : l4i;
#pragma unroll
        for (int i = 15; i >= 0; --i) {
          wre[half][i] = cr; wim[half][i] = ci;
          const float mr = (i & 3) ? ar : l5r, mi = (i & 3) ? ai : l5i;
          const float nr = cr * mr - ci * mi, ni = cr * mi + ci * mr; cr = nr; ci = ni;
        }
      }
      bf16x8 au_n = *(const bf16x8*)(ub + (long)l31 * INW + 8 * h);
      f32x16 z; for (int i = 0; i < 16; ++i) z[i] = 0.f;
#pragma nounroll
      for (int ch = 0; ch < 16; ++ch) {
        const bf16x8 au = au_n;
        if (ch + 1 < 16) au_n = *(const bf16x8*)(ub + (long)((ch + 1) * 32 + l31) * INW + 8 * h);
#pragma unroll
        for (int half = 0; half < 2; ++half) {
          const f32x16 bre = MFMA32(au, bfrag[half], z), bim = MFMA32(au, bfrag[2 + half], z);
          float sr = 0.f, si = 0.f;
#pragma unroll
          for (int i = 0; i < 16; ++i) { sr += wre[half][i] * bre[i] - wim[half][i] * bim[i]; si += wre[half][i] * bim[i] + wim[half][i] * bre[i]; }
          sr += shflx(sr, 32, lane); si += shflx(si, 32, lane);
          const float nr = l32r[half] * Hr[half] - l32i[half] * Hi[half] + sr, ni = l32r[half] * Hi[half] + l32i[half] * Hr[half] + si;
          Hr[half] = nr; Hi[half] = ni;
        }
      }
      if (h == 0) {
        hend[wave * 128 + l31] = Hr[0]; hend[wave * 128 + 64 + l31] = Hi[0];
        hend[wave * 128 + 32 + l31] = Hr[1]; hend[wave * 128 + 96 + l31] = Hi[1];
      }
    }
    __syncthreads();
    for (int pass = 1; pass < 2; ++pass) {
      if (pass == 1) {
        float pr_ = lr, pi_ = li;
        for (int k = 0; k < 9; ++k) { float nr = pr_ * pr_ - pi_ * pi_, ni = 2.f * pr_ * pi_; pr_ = nr; pi_ = ni; }
        hr = 0.f; hi = 0.f;
        for (int v = 0; v < wave; ++v) { float er = hend[v * 128 + lane], ei = hend[v * 128 + 64 + lane]; float nr = pr_ * hr - pi_ * hi + er, ni = pr_ * hi + pi_ * hr + ei; hr = nr; hi = ni; }
      }
      if (pass == 1 || wave < 7) {
        const int cch = lane & 15, kqq = lane >> 4;
        bf16x8 au_n = *(const bf16x8*)(ub + (long)l31 * INW + 8 * h);
        u16 us_n[8] = {0, 0, 0, 0, 0, 0, 0, 0};
        if (pass == 1) for (int q = 0; q < 8; ++q) us_n[q] = ub[(long)(16 * (q >> 2) + 4 * kqq + (q & 3)) * INW + cch];
#pragma nounroll
        for (int ch = 0; ch < 16; ++ch) {
          u16* up = ub + (long)(ch * 32) * INW;
          const bf16x8 au = au_n;
          u16 us[8];
          for (int q = 0; q < 8; ++q) us[q] = us_n[q];
          if (ch + 1 < 16) {
            const u16* un = up + (long)32 * INW;
            au_n = *(const bf16x8*)(un + (long)l31 * INW + 8 * h);
            if (pass == 1) for (int q = 0; q < 8; ++q) us_n[q] = un[(long)(16 * (q >> 2) + 4 * kqq + (q & 3)) * INW + cch];
          }
          f32x16 z; for (int i = 0; i < 16; ++i) z[i] = 0.f;
          for (int nt = 0; nt < 4; ++nt) {
            f32x16 bu = MFMA32(au, bfrag[nt], z);
            for (int i = 0; i < 16; ++i) buf[crow(i, h) * RSF + (nt >> 1) * 64 + (nt & 1) * 32 + l31] = bu[i];
          }
          __builtin_amdgcn_wave_barrier();
          {
            float sre[32], sim[32];
#pragma unroll
            for (int t = 0; t < 32; ++t) { sre[t] = buf[t * RSF + lane]; sim[t] = buf[t * RSF + 64 + lane]; }
#pragma unroll
            for (int t = 0; t < 32; ++t) {
              float nr = lr * hr - li * hi + sre[t], ni = lr * hi + li * hr + sim[t]; hr = nr; hi = ni; sre[t] = hr; sim[t] = hi;
            }
            if (pass == 1) {
#pragma unroll
              for (int t = 0; t < 32; ++t) { buf[t * RSF + lane] = sre[t]; buf[t * RSF + 64 + lane] = sim[t]; }
            }
          }
          __builtin_amdgcn_wave_barrier();
          if (pass == 1) {
            for (int mt = 0; mt < 2; ++mt) {
              f32x4 y = {0.f, 0.f, 0.f, 0.f};
              for (int s2 = 0; s2 < 4; ++s2) {
                const float* hp = buf + (16 * mt + cch) * RSF + 32 * s2 + 8 * kqq;
                f32x4 x0 = *(const f32x4*)hp, x1 = *(const f32x4*)(hp + 4);
                uint4 a = {pack2(x0[0], x0[1]), pack2(x0[2], x0[3]), pack2(x1[0], x1[1]), pack2(x1[2], x1[3])};
                y = MFMA16(__builtin_bit_cast(bf16x8, a), cfrag[s2], y);
              }
              for (int j = 0; j < 4; ++j) {
                int t = 16 * mt + 4 * kqq + j;
                float yv = y[j] + dskip * bf2f(us[4 * mt + j]);
                up[(long)t * INW + cch] = f2bf(gelu_tanh(yv));
              }
            }
            __builtin_amdgcn_wave_barrier();
          }
        }
      }
      if (pass == 0) { hend[wave * 128 + lane] = hr; hend[wave * 128 + 64 + lane] = hi; __syncthreads(); }
    }
    __syncthreads();
  }
}


#define XB_TMO      128
#define XB_XCNT(j)  (256  + 64 * (j))
#define XB_XSUB(j)  (1280 + 64 * (j))
#define XB_XGEN(j)  (2304 + 64 * (j))
#define XB_TOP      3328
#define XB_TOPGEN   3392
#define XCD_BAR_WORDS 3456
#define XB_SPIN_CAP (1u << 22)
DI unsigned xb_ld(unsigned* p)              { return __hip_atomic_load(p, __ATOMIC_RELAXED, __HIP_MEMORY_SCOPE_AGENT); }
DI unsigned xb_add(unsigned* p, unsigned v) { return __hip_atomic_fetch_add(p, v, __ATOMIC_RELAXED, __HIP_MEMORY_SCOPE_AGENT); }
DI unsigned xb_xcc_id() { return (unsigned)__builtin_amdgcn_s_getreg((3 << 11) | 20) & 0xFu; }
#define XB_SPIN(cond, bar) do { unsigned _sp = 0; while (cond) { __builtin_amdgcn_s_sleep(1); \
    if ((++_sp & 255u) == 0u) { if (xb_ld(&(bar)[XB_TMO])) break; if (_sp > XB_SPIN_CAP) { atomicAdd(&(bar)[XB_TMO], 1u); break; } } } } while (0)
struct XcdBarrier { unsigned* bar; unsigned x; volatile LAS unsigned* st; };
DI XcdBarrier xcd_barrier_post(unsigned* bar, volatile LAS unsigned* st) {
  XcdBarrier b; b.bar = bar; b.x = xb_xcc_id(); b.st = st;
  if (threadIdx.x == 0) (void)xb_add(&bar[XB_XCNT(b.x)], 1u);
  return b;
}
DI void xcd_barrier_complete(unsigned* bar, unsigned x, unsigned& nloc, unsigned& nx) {
  const unsigned G = gridDim.x * gridDim.y * gridDim.z;
  unsigned sum, cnt, mine, sp = 0u;
  for (;;) {
    sum = 0u; cnt = 0u; mine = 0u;
#pragma unroll
    for (unsigned j = 0; j < 16; ++j) { const unsigned c = xb_ld(&bar[XB_XCNT(j)]); sum += c; cnt += (c > 0u) ? 1u : 0u; mine = (j == x) ? c : mine; }
    if (sum == G) break;
    __builtin_amdgcn_s_sleep(1);
    if ((++sp & 255u) == 0u) { if (xb_ld(&bar[XB_TMO])) break; if (sp > XB_SPIN_CAP) { atomicAdd(&bar[XB_TMO], 1u); break; } }
  }
  nloc = mine > 0u ? mine : 1u; nx = cnt > 0u ? cnt : 1u;
}
DI void xcd_barrier(const XcdBarrier& b) {
  asm volatile("s_waitcnt vmcnt(0)" ::: "memory");
  __syncthreads();
  if (threadIdx.x == 0) {
    unsigned* bar = b.bar;
    __builtin_amdgcn_s_waitcnt(0);
    unsigned nloc = b.st[0], nx = b.st[1];
    if (nloc == 0u) { xcd_barrier_complete(bar, b.x, nloc, nx); b.st[0] = nloc; b.st[1] = nx; }
    const unsigned old = xb_add(&bar[XB_XSUB(b.x)], 1u);
    const unsigned gen = old / nloc;
    if (old + 1u == (gen + 1u) * nloc) {
      __builtin_amdgcn_fence(__ATOMIC_RELEASE, "agent");
      asm volatile("s_waitcnt vmcnt(0)" ::: "memory");
      const unsigned og = xb_add(&bar[XB_TOP], 1u);
      const unsigned tg = og / nx;
      if (og + 1u == (tg + 1u) * nx) xb_add(&bar[XB_TOPGEN], 1u);
      else XB_SPIN(xb_ld(&bar[XB_TOPGEN]) == tg, bar);
      __builtin_amdgcn_fence(__ATOMIC_ACQUIRE, "agent");
      xb_add(&bar[XB_XGEN(b.x)], 1u);
      asm volatile("s_waitcnt vmcnt(0)" ::: "memory");
    } else {
      XB_SPIN(xb_ld(&bar[XB_XGEN(b.x)]) == gen, bar);
      __builtin_amdgcn_fence(__ATOMIC_ACQUIRE, "agent");
      asm volatile("s_waitcnt vmcnt(0)" ::: "memory");
    }
  }
  __syncthreads();
}

__global__ void __launch_bounds__(NTHR) mega(Params p) {
  extern __shared__ __attribute__((aligned(16))) char smem[];

  const int ph_lo = p.ph_lo, ph_hi = p.ph_hi;
  const int WV = __builtin_amdgcn_readfirstlane(threadIdx.x >> 6);
  volatile LAS unsigned* xst = (volatile LAS unsigned*)(smem + LDS_BYTES - 16);
  if (threadIdx.x == 0) { xst[0] = 0u; xst[1] = 0u; }
  __syncthreads();
  (void)xcd_barrier_post((unsigned*)(p.ws + WS_BAR), xst);
  for (int ph = ph_lo; ph < ph_hi; ++ph) {
    if (ph % PH_PER_LAYER == 6 || (ph % PH_PER_LAYER == 0 && ph > 0)) continue;
    if (ph_hi > 4096) cg::this_grid().sync();
    if (ph > ph_lo) {
      CP pb_ = (CP)__builtin_amdgcn_kernarg_segment_ptr(); asm volatile("" : "+s"(pb_));
      XcdBarrier xbar; xbar.bar = (unsigned*)(pb_->ws + WS_BAR); xbar.x = xb_xcc_id(); xbar.st = (volatile LAS unsigned*)(smem + LDS_BYTES - 16);
      xcd_barrier(xbar);
    }
    const int BID = get_bid(), G = get_grid();
    CP pp = (CP)__builtin_amdgcn_kernarg_segment_ptr(); asm volatile("" : "+s"(pp));
    char* ws = pp->ws;
    u16* proj = (u16*)(ws + WS_PROJ);
    u16* xn = (u16*)(ws + WS_XN);
    u16* pb = (u16*)(ws + WS_PB);
    u16* mg = (u16*)(ws + WS_MG);
    float* lse = (float*)(ws + WS_LSE);
    u16* hbuf = proj;
    const u16* WIN = (const u16*)(ws + WS_WIN); const u16* WG = (const u16*)(ws + WS_WG); const u16* WB = (const u16*)(ws + WS_WB);
    const u16* WO = (const u16*)(ws + WS_WO); const u16* WUP = (const u16*)(ws + WS_WUP); const u16* WDN = (const u16*)(ws + WS_WDN);
    const u16* WGLU = (const u16*)(ws + WS_WGLU);
    float* xres = pp->out;
    const int l = ph / PH_PER_LAYER, k = ph % PH_PER_LAYER;
    const float* xin = (l == 0) ? pp->in[0] : xres;
    switch (k) {
      case 0: {
        if (l == 0) phase_rmsnorm(WV, xin, pp->in[1] + (size_t)l * DM, xn);
        phase_wprep(WV, pp, l, smem, 0x1fff);
      } break;
      case 1: {
        const int nR = INW / 256, nC = TOK / 256, nwg = nR * nC;
        for (int id = BID; id < nwg; id += G) {
          int pr, pc; tile_map(id, nwg, nR, nC, pr, pc);
          EpiStore2 E{proj, INW, pr * 256, pr * 256 + 128};
          gemm_tile_staged(WV, smem, WIN, DM, pr * 256, pr * 256 + 128, xn, DM, pc * 256, DM, E);
        }
      } break;
      case 2: {
        mix_s5(WV, pp, l, proj, smem);
        mix_sb(WV, proj, smem);
        mix_dil(WV, proj, lse, pp->in[5], smem);
        mix_pool(WV, proj, pb);
        if (l > 0) phase_wprep(WV, pp, l, smem, 1 << 10);
      } break;
      case 3: {
        const int nR = 4, nC = TOK / 256, nwg = nR * nC;
        for (int id = BID; id < nwg; id += G) {
          int pr, pc; tile_map(id, nwg, nR, nC, pr, pc);
          EpiGated<1> E{proj, INW, O2 + 512 + pr * 128};
          gemm_tile_staged(WV, smem, WGLU, 512, pr * 128, 512 + pr * 128, proj + O3, INW, pc * 256, 512, E);
        }
        mix_dil_merge(WV, proj, lse);
      } break;
      case 4: {
        const int nR = 4, nC = TOK / 256, nwg = nR * nC;
        for (int id = BID; id < nwg; id += G) {
          int pr, pc; tile_map(id, nwg, nR, nC, pr, pc);
#pragma nounroll
          for (int b = 0; b < 4; ++b) {
            const int q = pr * 3 + b;
            u16* sd = (b == 3) ? mg + pr * 256 : proj + (q < 8 ? 768 + 256 * q : (q < 10 ? 256 * (q - 8) : 3840 + 256 * (q - 10)));
            EpiSig E1{sd, b == 3 ? DM : INW, pc * 256};
            gemm_tile(WV, smem, WG + (size_t)b * DM * DM, DM, pr * 256, pr * 256 + 128, xn, DM, pc * 256, DM, E1);
          }
          AccT acc = {};
#pragma nounroll
          for (int b = 0; b < 4; ++b) {
            const int Kb = (b == 1) ? 256 : 512, ldy = (b == 0) ? 512 : INW;
            const u16* yb = (b == 0) ? pb : proj + (b == 1 ? O1 : (b == 2 ? O2 : O2 + 512));
            const u16* wb = WB + DM * (b == 0 ? 0 : (b == 1 ? 512 : (b == 2 ? 768 : 1280)));
            gemm_core(WV, smem, wb, Kb, pr * 256, pr * 256 + 128, yb, ldy, pc * 256, Kb, acc);
            if (b < 3) {
              const int q = pr * 3 + b, q1 = q + 1;
              u16* sc = proj + (q < 8 ? 768 + 256 * q : (q < 10 ? 256 * (q - 8) : 3840 + 256 * (q - 10)));
              u16* sn = (b == 2) ? mg + pr * 256 : proj + (q1 < 8 ? 768 + 256 * q1 : (q1 < 10 ? 256 * (q1 - 8) : 3840 + 256 * (q1 - 10)));
              EpiRescale E2{sc, INW, sn, b == 2 ? DM : INW, pc * 256};
              apply_epi(WV, acc, pc * 256, E2);
            }
          }
          EpiFinalGate E3{mg, pr * 256, pc * 256};
          apply_epi_staged(WV, smem, acc, pc * 256, E3);
        }
      } break;
      case 5: {
        const int nR = 4, nC = TOK / 256, nwg = nR * nC;
        for (int id = BID; id < nwg; id += G) {
          int pr, pc; tile_map(id, nwg, nR, nC, pr, pc);
          AccT acc = {};
          gemm_core(WV, smem, WO, DM, pr * 256, pr * 256 + 128, mg, DM, pc * 256, DM, acc);
          resid_norm_epi(WV, smem, acc, pc * 256, xin, xres, pr * 256, pc, pr, (unsigned)(ph + 1), (u64*)(ws + WS_SLAB), pp->in[18] + (size_t)l * DM, xn, 1);
        }
      } break;
      case 7: {
        const int nR = FFN / 128, nC = TOK / 256, nwg = nR * nC;
        for (int id = BID; id < nwg; id += G) {
          int pr, pc; tile_map(id, nwg, nR, nC, pr, pc);
          EpiGated<0> E{hbuf, FFN, pr * 128};
          gemm_tile_staged(WV, smem, WUP, DM, pr * 128, FFN + pr * 128, xn, DM, pc * 256, DM, E);
        }
      } break;
      case 8: {
        const int nR = 4, nC = TOK / 256, nwg = nR * nC;
        for (int id = BID; id < nwg; id += G) {
          int pr, pc; tile_map(id, nwg, nR, nC, pr, pc);
          AccT acc = {};
          gemm_core(WV, smem, WDN, FFN, pr * 256, pr * 256 + 128, hbuf, FFN, pc * 256, FFN, acc);
          resid_norm_epi(WV, smem, acc, pc * 256, xres, xres, pr * 256, pc, pr, (unsigned)(ph + 1), (u64*)(ws + WS_SLAB), (l < DEPTH - 1) ? pp->in[1] + (size_t)(l + 1) * DM : pp->in[21], xn, (l < DEPTH - 1) ? 1 : 2);
        }
        if (l < DEPTH - 1) phase_wprep(WV, pp, l + 1, smem, 0x1fff & ~(1 << 10));
      } break;
    }
  }
}

extern "C" void kernel_launch(void* const* d_in, const int* in_sizes, int n_in, void* d_out, int out_size,
                              void* d_ws, size_t ws_size, hipStream_t stream) {
  static int grid = 0;
  if (grid == 0) {
    if (n_in != 22 || ws_size < WS_END) { fprintf(stderr, "kernel_launch: unexpected n_in %d / ws_size %zu (need %zu)\n", n_in, ws_size, (size_t)WS_END); grid = -1; return; }
    int dev = 0, cus = 0, per_cu = 0;
    hipGetDevice(&dev);
    hipDeviceGetAttribute(&cus, hipDeviceAttributeMultiprocessorCount, dev);
    if (hipFuncSetAttribute((const void*)mega, hipFuncAttributeMaxDynamicSharedMemorySize, LDS_BYTES) != hipSuccess) { fprintf(stderr, "hipFuncSetAttribute failed\n"); grid = -1; return; }
    if (hipOccupancyMaxActiveBlocksPerMultiprocessor(&per_cu, (const void*)mega, NTHR, LDS_BYTES) != hipSuccess || per_cu < 1) { fprintf(stderr, "occupancy query failed (%d)\n", per_cu); per_cu = 1; (void)hipGetLastError(); }
    grid = cus * per_cu;
  }
  if (grid < 0) return;
  if (hipMemsetAsync((char*)d_ws + WS_BAR, 0, WS_END - WS_BAR, stream) != hipSuccess) { fprintf(stderr, "memset of barrier words failed\n"); return; }
  Params p{};
  for (int i = 0; i < 22; ++i) p.in[i] = (const float*)d_in[i];
  p.out = (float*)d_out; p.ws = (char*)d_ws;
#if ONE_LAUNCH
  p.ph_lo = 0; p.ph_hi = N_PHASES;
  void* args[] = {&p};
  hipError_t e = hipLaunchCooperativeKernel((const void*)mega, dim3(grid), dim3(NTHR), args, LDS_BYTES, stream);
  if (e != hipSuccess) fprintf(stderr, "cooperative launch failed: %s (grid %d)\n", hipGetErrorString(e), grid);
#else
  for (int ph = 0; ph < N_PHASES; ++ph) {
    p.ph_lo = ph; p.ph_hi = ph + 1;
    hipLaunchKernelGGL(mega, dim3(grid), dim3(NTHR), LDS_BYTES, stream, p);
  }
#endif
}
```
